# Optimizing an MI355X kernel written in HIP

```python
import math
import jax
import jax.numpy as jnp
from jax import lax
import numpy as np

D_MODEL = 1024
BATCH = 2
SEQ = 16384
DEPTH = 2

N_HEADS = 8
Q_LORA = 256
KV_LORA = 128
QK_NOPE = 64
QK_ROPE = 32
QK_DIM = QK_NOPE + QK_ROPE
V_DIM = 64
ATTN_WIDTH = N_HEADS * V_DIM
ROPE_THETA = 10000.0
Q_BLOCK = 128

D_SSM = 512
GROUP_CH = 16
N_GROUPS = D_SSM // GROUP_CH
STATE = 64
DT_MIN = 0.001
DT_MAX = 0.1

D_FF = ((8 * D_MODEL + 3 * 256 - 1) // (3 * 256)) * 256

IN_COLS = Q_LORA + KV_LORA + QK_ROPE + D_SSM + 2 * D_MODEL

EPS = 1e-6

kernel_name = "mla_s5_gated_hybrid_encoder"


def _rmsnorm(x, g):
    xf = x.astype(jnp.float32)
    y = xf * lax.rsqrt(jnp.mean(xf * xf, axis=-1, keepdims=True) + EPS)
    return (y * g.astype(jnp.float32)).astype(x.dtype)


def _rope(x, cos, sin):
    half = x.shape[-1] // 2
    x1, x2 = x[..., :half], x[..., half:]
    c = cos[None, :, None, :].astype(x.dtype)
    s = sin[None, :, None, :].astype(x.dtype)
    return jnp.concatenate([x1 * c - x2 * s, x2 * c + x1 * s], axis=-1)


def _mla(cq, ckv, k_rope, cos, sin, q_lat_g, w_uq, kv_lat_g, w_uk, w_uv, q_norm_g, k_norm_g):
    bsz, seq, _ = cq.shape
    cq = _rmsnorm(cq, q_lat_g)
    ckv = _rmsnorm(ckv, kv_lat_g)
    q = (cq @ w_uq).reshape(bsz, seq, N_HEADS, QK_DIM)
    k_nope = (ckv @ w_uk).reshape(bsz, seq, N_HEADS, QK_NOPE)
    v = (ckv @ w_uv).reshape(bsz, seq, N_HEADS, V_DIM)
    k_r = jnp.broadcast_to(k_rope[:, :, None, :], (bsz, seq, N_HEADS, QK_ROPE))
    k = jnp.concatenate([k_nope, k_r], axis=-1)
    q = _rmsnorm(q, q_norm_g)
    k = _rmsnorm(k, k_norm_g)
    q = jnp.concatenate([q[..., :QK_NOPE], _rope(q[..., QK_NOPE:], cos, sin)], axis=-1)
    k = jnp.concatenate([k[..., :QK_NOPE], _rope(k[..., QK_NOPE:], cos, sin)], axis=-1)
    scale = 1.0 / math.sqrt(QK_DIM)
    n_blk = seq // Q_BLOCK
    qb = q.reshape(bsz, n_blk, Q_BLOCK, N_HEADS, QK_DIM).transpose(1, 0, 2, 3, 4)

    def attend(qi):
        s = jnp.einsum('bqhd,bkhd->bhqk', qi, k, preferred_element_type=jnp.float32) * scale
        p = jax.nn.softmax(s, axis=-1)
        return jnp.einsum('bhqk,bkhv->bqhv', p.astype(v.dtype), v)

    o = lax.map(attend, qb)
    return o.transpose(1, 0, 2, 3, 4).reshape(bsz, seq, ATTN_WIDTH)


def _scan_combine(left, right):
    a1, b1 = left
    a2, b2 = right
    return a1 * a2, a2 * b1 + b2


def _s5_bidir(u, lam_re, lam_im, log_dt, b_re, b_im, c_re, c_im, d_skip):
    bsz, seq, _ = u.shape
    uf = u.astype(jnp.float32)
    ug = uf.reshape(bsz, seq, N_GROUPS, GROUP_CH).astype(jnp.complex64)
    y = d_skip.astype(jnp.float32) * uf
    for direction in range(2):
        lam = lax.complex(lam_re[direction].astype(jnp.float32), lam_im[direction].astype(jnp.float32))
        dt = jnp.exp(log_dt[direction].astype(jnp.float32))[:, None]
        lam_bar = jnp.exp(lam * dt)
        bmat = lax.complex(b_re[direction].astype(jnp.float32), b_im[direction].astype(jnp.float32))
        b_bar = ((lam_bar - 1.0) / lam)[..., None] * bmat
        bu = jnp.einsum('bsgc,gpc->bsgp', ug, b_bar)
        a = jnp.broadcast_to(lam_bar[None, None], (1, seq, N_GROUPS, STATE))
        _, states = lax.associative_scan(_scan_combine, (a, bu), reverse=(direction == 1), axis=1)
        cmat = lax.complex(c_re[direction].astype(jnp.float32), c_im[direction].astype(jnp.float32))
        y = y + jnp.real(jnp.einsum('bsgp,gcp->bsgc', states, cmat)).reshape(bsz, seq, D_SSM)
    return y.astype(u.dtype)


def _swiglu(x, w_gate, w_up, w_down):
    return (jax.nn.silu(x @ w_gate) * (x @ w_up)) @ w_down


def setup_inputs(seed: int = 0) -> dict:
    key = jax.random.key(seed)
    ks = jax.random.split(key, 32)

    def nrm(k, shape, fan_in):
        return jax.random.normal(k, shape, jnp.float32) * (fan_in ** -0.5)

    def gain(k, shape):
        return 1.0 + 0.02 * jax.random.normal(k, shape, jnp.float32)

    L = DEPTH
    n_idx = jnp.arange(STATE, dtype=jnp.float32)
    lam_re = -0.5 + 0.01 * jax.random.normal(ks[15], (L, 2, N_GROUPS, STATE), jnp.float32)
    lam_im = math.pi * n_idx + 0.01 * jax.random.normal(ks[16], (L, 2, N_GROUPS, STATE), jnp.float32)
    log_dt = jax.random.uniform(ks[17], (L, 2, N_GROUPS), jnp.float32,
                                minval=math.log(DT_MIN), maxval=math.log(DT_MAX))
    return {
        "x": jax.random.normal(ks[0], (BATCH, SEQ, D_MODEL), jnp.float32),
        "norm1_g": gain(ks[1], (L, D_MODEL)),
        "w_in": nrm(ks[2], (L, D_MODEL, IN_COLS), D_MODEL),
        "q_lat_g": gain(ks[3], (L, Q_LORA)),
        "w_uq": nrm(ks[4], (L, Q_LORA, N_HEADS * QK_DIM), Q_LORA),
        "kv_lat_g": gain(ks[5], (L, KV_LORA)),
        "w_uk": nrm(ks[6], (L, KV_LORA, N_HEADS * QK_NOPE), KV_LORA),
        "w_uv": nrm(ks[7], (L, KV_LORA, N_HEADS * V_DIM), KV_LORA),
        "q_norm_g": gain(ks[8], (L, QK_DIM)),
        "k_norm_g": gain(ks[9], (L, QK_DIM)),
        "w_attn_up": nrm(ks[10], (L, ATTN_WIDTH, D_MODEL), ATTN_WIDTH),
        "ssm_lam_re": lam_re,
        "ssm_lam_im": lam_im,
        "ssm_log_dt": log_dt,
        "ssm_b_re": nrm(ks[11], (L, 2, N_GROUPS, STATE, GROUP_CH), 2 * GROUP_CH),
        "ssm_b_im": nrm(ks[12], (L, 2, N_GROUPS, STATE, GROUP_CH), 2 * GROUP_CH),
        "ssm_c_re": nrm(ks[13], (L, 2, N_GROUPS, GROUP_CH, STATE), 2 * STATE),
        "ssm_c_im": nrm(ks[14], (L, 2, N_GROUPS, GROUP_CH, STATE), 2 * STATE),
        "ssm_d": jax.random.normal(ks[18], (L, D_SSM), jnp.float32),
        "w_glu": nrm(ks[19], (L, D_SSM, 2 * D_MODEL), D_SSM),
        "w_o": nrm(ks[20], (L, D_MODEL, D_MODEL), D_MODEL),
        "norm2_g": gain(ks[21], (L, D_MODEL)),
        "w_ffn_gate": nrm(ks[22], (L, D_MODEL, D_FF), D_MODEL),
        "w_ffn_up": nrm(ks[23], (L, D_MODEL, D_FF), D_MODEL),
        "w_ffn_down": nrm(ks[24], (L, D_FF, D_MODEL), D_FF),
    }


def reference(x, norm1_g, w_in, q_lat_g, w_uq, kv_lat_g, w_uk, w_uv, q_norm_g, k_norm_g,
              w_attn_up, ssm_lam_re, ssm_lam_im, ssm_log_dt, ssm_b_re, ssm_b_im, ssm_c_re,
              ssm_c_im, ssm_d, w_glu, w_o, norm2_g, w_ffn_gate, w_ffn_up, w_ffn_down):
    seq = x.shape[1]
    inv_freq = 1.0 / (ROPE_THETA ** (jnp.arange(0, QK_ROPE, 2, dtype=jnp.float32) / QK_ROPE))
    ang = jnp.arange(seq, dtype=jnp.float32)[:, None] * inv_freq[None, :]
    cos, sin = jnp.cos(ang), jnp.sin(ang)

    o1 = Q_LORA
    o2 = o1 + KV_LORA
    o3 = o2 + QK_ROPE
    o4 = o3 + D_SSM
    o5 = o4 + D_MODEL
    for l in range(DEPTH):
        xn = _rmsnorm(x, norm1_g[l])
        proj = xn @ w_in[l]
        cq, ckv, k_rope = proj[..., :o1], proj[..., o1:o2], proj[..., o2:o3]
        u = proj[..., o3:o4]
        gate_a = jax.nn.sigmoid(proj[..., o4:o5])
        gate_b = jax.nn.sigmoid(proj[..., o5:])

        attn = _mla(cq, ckv, k_rope, cos, sin, q_lat_g[l], w_uq[l], kv_lat_g[l], w_uk[l],
                    w_uv[l], q_norm_g[l], k_norm_g[l])
        branch_a = attn @ w_attn_up[l]

        y = _s5_bidir(u, ssm_lam_re[l], ssm_lam_im[l], ssm_log_dt[l], ssm_b_re[l], ssm_b_im[l],
                      ssm_c_re[l], ssm_c_im[l], ssm_d[l])
        z = jax.nn.gelu(y) @ w_glu[l]
        branch_b = z[..., :D_MODEL] * jax.nn.sigmoid(z[..., D_MODEL:])

        x = x + (gate_a * branch_a + gate_b * branch_b) @ w_o[l]
        x = x + _swiglu(_rmsnorm(x, norm2_g[l]), w_ffn_gate[l], w_ffn_up[l], w_ffn_down[l])
    return x
```

```cpp
#include <hip/hip_runtime.h>
#include <hip/hip_cooperative_groups.h>
#include <cstdio>
#include <cstdint>
namespace cg = cooperative_groups;

#define LAS __attribute__((address_space(3)))
typedef unsigned short bf16_t;
typedef short bf16x8 __attribute__((ext_vector_type(8)));
typedef short s16x4 __attribute__((ext_vector_type(4)));
typedef float f32x4 __attribute__((ext_vector_type(4)));
typedef float f32x2 __attribute__((ext_vector_type(2)));
typedef float f32x16 __attribute__((ext_vector_type(16)));
typedef unsigned u32x4 __attribute__((ext_vector_type(4)));
typedef unsigned u32x2 __attribute__((ext_vector_type(2)));

constexpr int DM = 1024, BATCH = 2, SEQ = 16384, M = BATCH * SEQ, DEPTH = 2;
constexpr int NH = 8, QKD = 96, VD = 64;
constexpr int NG = 32, ST = 64;
constexpr int DFF = 2816;
constexpr int INC = 2976;
constexpr int PROJ_N = 3072;
constexpr int LDQ = 768, LDKV = 1280;
constexpr float EPS = 1e-6f;
constexpr int CHUNK = 512, NCH = SEQ / CHUNK;

constexpr size_t MiB = 1u << 20;
constexpr size_t WS_LAMB = 64 * 1024;
constexpr size_t WS_BBAR = 1 * MiB;
constexpr size_t WS_E = 2 * MiB;
constexpr size_t WS_W = 4 * MiB;
constexpr size_t W_LAYER = 30 * MiB;
constexpr size_t W0 = 0, W1 = 6291456, W2 = 6684672, W3 = 7012352, W4 = 8585216, W5 = 10682368, W6 = 12779520, W7 = 24313856;
constexpr size_t WS_PROJ = 64 * MiB;
constexpr size_t WS_Q = 256 * MiB;
constexpr size_t WS_KV = 304 * MiB;
constexpr size_t WS_XN = 256 * MiB;
constexpr size_t WS_H = 256 * MiB;
constexpr size_t WS_YF = 384 * MiB;
constexpr size_t WS_MIX = 384 * MiB;
constexpr size_t WS_HN = 384 * MiB;
constexpr size_t WS_YG = 448 * MiB;
constexpr size_t WS_ATT = 480 * MiB;
constexpr size_t WS_END = 512 * MiB;
constexpr int LDS_BYTES = 131072 + 256;

struct Args { const float* in[25]; float* out; unsigned char* ws; int ph_lo, ph_hi; };

__device__ __forceinline__ unsigned cvt_pk_bf16(float lo, float hi) { unsigned r; asm("v_cvt_pk_bf16_f32 %0, %1, %2" : "=v"(r) : "v"(lo), "v"(hi)); return r; }
__device__ __forceinline__ float bf_lo(unsigned w) { return __uint_as_float(w << 16); }
__device__ __forceinline__ float bf_hi(unsigned w) { return __uint_as_float(w & 0xffff0000u); }
__device__ __forceinline__ float bf2f(bf16_t h) { return __uint_as_float(((unsigned)h) << 16); }
__device__ __forceinline__ bf16_t f2bf(float f) { return (bf16_t)(cvt_pk_bf16(f, 0.f) & 0xffffu); }
__device__ __forceinline__ float sigm(float x) { return __builtin_amdgcn_rcpf(1.f + __expf(-x)); }
__device__ __forceinline__ float wave_sum(float v) {
#pragma unroll
    for (int o = 1; o < 64; o <<= 1) v += __shfl_xor(v, o);
    return v;
}

namespace pg8 {
constexpr int BM = 256, BK = 64, HALF = 128, HTB = HALF * BK * 2, NXCD = 8, WGM = 8;
__host__ __device__ __forceinline__ int lds_byte(int r, int c) { const int st = (r >> 4) * 2 + (c >> 5), rr = r & 15, cc = c & 31, ob = rr * 64 + cc * 2; return st * 1024 + (ob ^ (((ob >> 9) & 1) << 5)); }
__host__ __device__ __forceinline__ void stage_rc(int b, int& R, int& C) { const int st = b / 1024, sb = b % 1024, swz = sb ^ (((sb >> 9) & 1) << 5); R = (st >> 1) * 16 + swz / 64; C = (st & 1) * 32 + (swz % 64) / 2; }
__host__ __device__ __forceinline__ int perm32(int rho) { const int n = rho >> 4, i = rho & 15; return 8 * (i >> 2) + 4 * n + (i & 3); }

struct Unit { int pm, pn; };
struct Gemm { const bf16_t* A; const bf16_t* Bt; int M, N, K, lda; };

struct StaticOrder {
    int nM, nN, nwg, G, c;
    __device__ void init(int M_, int N_, int G_, int c_) { nM = M_ / BM; nN = N_ / BM; nwg = nM * nN; G = G_; c = c_; }
    __device__ bool next(int i, Unit& u) const {
        const long L = (long)i * G + c; if (L >= nwg) return false;
        int wgid = (int)L; { const int q = nwg / NXCD, r = nwg % NXCD, xcd = wgid % NXCD, off = wgid / NXCD; wgid = (xcd < r ? xcd * (q + 1) : r * (q + 1) + (xcd - r) * q) + off; }
        const int nig = WGM * nN, gid = wgid / nig, fm = gid * WGM, gsz = (nM - fm) < WGM ? (nM - fm) : WGM;
        u.pm = fm + ((wgid % nig) % gsz); u.pn = (wgid % nig) / gsz; return true;
    }
};

typedef f32x4 Acc[2][2][4][2];

struct EpiBf {
    static constexpr bool PERM = true;
    bf16_t* O; int ldc; int sig_from;
    __device__ __forceinline__ void operator()(const Acc& acc, const Unit& u, int wr, int wc, int fr, int fq) const {
        const int row0 = u.pm * BM + wr * 64 + fr, col0 = u.pn * BM + wc * 32 + 8 * fq; const bool sg = u.pn >= sig_from;
#pragma unroll
        for (int ai = 0; ai < 2; ++ai)
#pragma unroll
            for (int m = 0; m < 4; ++m) { bf16_t* rowp = O + (size_t)(row0 + ai * HALF + m * 16) * ldc + col0;
#pragma unroll
                for (int bj = 0; bj < 2; ++bj) { f32x4 v0 = acc[ai][bj][m][0], v1 = acc[ai][bj][m][1];
                    if (sg) {
#pragma unroll
                        for (int i = 0; i < 4; ++i) { v0[i] = sigm(v0[i]); v1[i] = sigm(v1[i]); } }
                    u32x4 w; w.x = cvt_pk_bf16(v0[0], v0[1]); w.y = cvt_pk_bf16(v0[2], v0[3]); w.z = cvt_pk_bf16(v1[0], v1[1]); w.w = cvt_pk_bf16(v1[2], v1[3]);
                    *(u32x4*)(rowp + bj * HALF) = w; }
                asm volatile("" ::: "memory"); }
    }
};
template <int MODE> struct EpiPair {
    static constexpr bool PERM = true;
    bf16_t* O; int ldc; const bf16_t* gate; int ldg, goff;
    __device__ __forceinline__ void operator()(const Acc& acc, const Unit& u, int wr, int wc, int fr, int fq) const {
        const int row0 = u.pm * BM + wr * 64 + fr, j00 = u.pn * 128 + wc * 16 + 4 * fq;
#pragma unroll
        for (int ai = 0; ai < 2; ++ai)
#pragma unroll
            for (int m = 0; m < 4; ++m) { const size_t row = (size_t)(row0 + ai * HALF + m * 16);
#pragma unroll
                for (int bj = 0; bj < 2; ++bj) { const int j0 = j00 + bj * 64; const f32x4 a = acc[ai][bj][m][0], b = acc[ai][bj][m][1]; float o[4];
                    if (MODE == 0) { const u32x2 gw = *(const u32x2*)(gate + row * ldg + goff + j0);
                        const float g0 = bf_lo(gw.x), g1 = bf_hi(gw.x), g2 = bf_lo(gw.y), g3 = bf_hi(gw.y);
                        o[0] = g0 * a[0] * sigm(b[0]); o[1] = g1 * a[1] * sigm(b[1]); o[2] = g2 * a[2] * sigm(b[2]); o[3] = g3 * a[3] * sigm(b[3]);
                    } else {
#pragma unroll
                        for (int i = 0; i < 4; ++i) o[i] = a[i] * sigm(a[i]) * b[i]; }
                    u32x2 w; w.x = cvt_pk_bf16(o[0], o[1]); w.y = cvt_pk_bf16(o[2], o[3]);
                    *(u32x2*)(O + row * ldc + j0) = w; }
                asm volatile("" ::: "memory"); }
    }
};
struct EpiGateAcc {
    static constexpr bool PERM = true;
    bf16_t* O; int ldc; const bf16_t* gate; int ldg, goff;
    __device__ __forceinline__ void operator()(const Acc& acc, const Unit& u, int wr, int wc, int fr, int fq) const {
        const int row0 = u.pm * BM + wr * 64 + fr, col0 = u.pn * BM + wc * 32 + 8 * fq;
#pragma unroll
        for (int ai = 0; ai < 2; ++ai) {
            u32x4 gw[4][2], mw[4][2];
#pragma unroll
            for (int m = 0; m < 4; ++m) { const size_t row = (size_t)(row0 + ai * HALF + m * 16);
#pragma unroll
                for (int bj = 0; bj < 2; ++bj) { const int col = col0 + bj * HALF; gw[m][bj] = *(const u32x4*)(gate + row * ldg + goff + col); mw[m][bj] = *(const u32x4*)(O + row * ldc + col); } }
#pragma unroll
            for (int m = 0; m < 4; ++m) { const size_t row = (size_t)(row0 + ai * HALF + m * 16);
#pragma unroll
                for (int bj = 0; bj < 2; ++bj) { const int col = col0 + bj * HALF; const f32x4 v0 = acc[ai][bj][m][0], v1 = acc[ai][bj][m][1];
                    const u32x4 g_ = gw[m][bj], m_ = mw[m][bj]; u32x4 w;
                    w.x = cvt_pk_bf16(bf_lo(g_.x) * v0[0] + bf_lo(m_.x), bf_hi(g_.x) * v0[1] + bf_hi(m_.x));
                    w.y = cvt_pk_bf16(bf_lo(g_.y) * v0[2] + bf_lo(m_.y), bf_hi(g_.y) * v0[3] + bf_hi(m_.y));
                    w.z = cvt_pk_bf16(bf_lo(g_.z) * v1[0] + bf_lo(m_.z), bf_hi(g_.z) * v1[1] + bf_hi(m_.z));
                    w.w = cvt_pk_bf16(bf_lo(g_.w) * v1[2] + bf_lo(m_.w), bf_hi(g_.w) * v1[3] + bf_hi(m_.w));
                    *(u32x4*)(O + row * ldc + col) = w; } }
            asm volatile("" ::: "memory"); }
    }
};
struct EpiRes {
    static constexpr bool PERM = false;
    const float* base; float* out;
    __device__ __forceinline__ void operator()(const Acc& acc, const Unit& u, int wr, int wc, int fr, int fq) const {
        const int row0 = u.pm * BM + wr * 64 + fr, col0 = u.pn * BM + wc * 32 + 4 * fq;
#pragma unroll
        for (int ai = 0; ai < 2; ++ai) {
            f32x4 bs[4][2][2];
#pragma unroll
            for (int m = 0; m < 4; ++m) { const size_t off = (size_t)(row0 + ai * HALF + m * 16) * DM + col0;
#pragma unroll
                for (int bj = 0; bj < 2; ++bj)
#pragma unroll
                    for (int n = 0; n < 2; ++n) bs[m][bj][n] = *(const f32x4*)(base + off + bj * HALF + n * 16); }
#pragma unroll
            for (int m = 0; m < 4; ++m) { const size_t off = (size_t)(row0 + ai * HALF + m * 16) * DM + col0;
#pragma unroll
                for (int bj = 0; bj < 2; ++bj)
#pragma unroll
                    for (int n = 0; n < 2; ++n) *(f32x4*)(out + off + bj * HALF + n * 16) = bs[m][bj][n] + acc[ai][bj][m][n]; }
            asm volatile("" ::: "memory"); }
    }
};

template <class Epi>
__device__ __forceinline__ void gemm_phase(LAS unsigned char* lds, const Gemm g, const StaticOrder& S, const Epi& E) {
    int tid = threadIdx.x; asm volatile("" : "+v"(tid));
    const int wid = __builtin_amdgcn_readfirstlane(tid >> 6), lane = tid & 63, wr = wid >> 2, wc = wid & 3, fr = lane & 15, fq = lane >> 4;
    const int K = g.K, nt = K / BK, lda = g.lda;
    unsigned voffA[2], voffB[2];
#pragma unroll
    for (int i = 0; i < 2; ++i) { int R, C; stage_rc(tid * 16 + i * 8192, R, C); const int Rb = Epi::PERM ? ((R & ~31) + perm32(R & 31)) : R;
        voffA[i] = (unsigned)(R * lda + C) * 2u; voffB[i] = (unsigned)(Rb * K + C) * 2u; }
    const size_t kstep = (size_t)(BK * 2);
    const size_t hA = (size_t)HALF * lda * 2, hB = (size_t)HALF * K * 2;
    const size_t tA = 2 * hA, tB = 2 * hB;
    const unsigned ldsw = (unsigned)wid * 1024u;
    const int aoff = lds_byte(wr * 64 + fr, fq * 8), boff = lds_byte(wc * 32 + fr, fq * 8);
#define PG8_SA(b, h) (((b) * 2 + (h)) * HTB)
#define PG8_SB(b, h) ((4 + (b) * 2 + (h)) * HTB)
#define PG8_STAGE(bufoff, gbase, voff) do { _Pragma("unroll") for (int _i = 0; _i < 2; ++_i) \
        __builtin_amdgcn_global_load_lds((const unsigned*)((const char*)(gbase) + (voff)[_i]), (LAS unsigned*)(lds + (bufoff) + ldsw + _i * 8192), 16, 0, 0); } while (0)
#define PG8_LDA(dst, b, h) do { _Pragma("unroll") for (int m = 0; m < 4; ++m) _Pragma("unroll") for (int k = 0; k < 2; ++k) dst[m][k] = *(const LAS bf16x8*)(lds + PG8_SA(b, h) + aoff + m * 2048 + k * 1024); } while (0)
#define PG8_LDB(dst, b, h) do { _Pragma("unroll") for (int n = 0; n < 2; ++n) _Pragma("unroll") for (int k = 0; k < 2; ++k) dst[n][k] = *(const LAS bf16x8*)(lds + PG8_SB(b, h) + boff + n * 2048 + k * 1024); } while (0)
#define PG8_MMA(ai, bj, At, Bt) do { __builtin_amdgcn_s_setprio(1); _Pragma("unroll") for (int m = 0; m < 4; ++m) _Pragma("unroll") for (int n = 0; n < 2; ++n) _Pragma("unroll") for (int k = 0; k < 2; ++k) \
        acc[ai][bj][m][n] = __builtin_amdgcn_mfma_f32_16x16x32_bf16(Bt[n][k], At[m][k], acc[ai][bj][m][n], 0, 0, 0); __builtin_amdgcn_s_setprio(0); } while (0)
#define PG8_WAIT_V(n) asm volatile("s_waitcnt vmcnt(" #n ")" ::: "memory")
#define PG8_WAIT_L(n) asm volatile("s_waitcnt lgkmcnt(" #n ")" ::: "memory")
#define PG8_BAR __builtin_amdgcn_s_barrier()
#define PG8_SCHED __builtin_amdgcn_sched_barrier(0)
    Unit cur, nxt; int ui = 0;
    if (!S.next(0, cur)) return;
    Acc acc;
#pragma unroll
    for (int a = 0; a < 2; ++a)
#pragma unroll
        for (int b = 0; b < 2; ++b)
#pragma unroll
            for (int m = 0; m < 4; ++m)
#pragma unroll
                for (int n = 0; n < 2; ++n) acc[a][b][m][n] = (f32x4){0.f, 0.f, 0.f, 0.f};
    bf16x8 At[4][2], B0[2][2], B1[2][2];
    const char* cA = (const char*)g.A + (size_t)cur.pm * tA; const char* cB = (const char*)g.Bt + (size_t)cur.pn * tB;
    PG8_STAGE(PG8_SB(0, 0), cB, voffB); PG8_STAGE(PG8_SB(0, 1), cB + hB, voffB); PG8_STAGE(PG8_SA(0, 0), cA, voffA); PG8_STAGE(PG8_SA(0, 1), cA + hA, voffA);
    if (wr == 1) PG8_BAR;
    PG8_WAIT_V(2); PG8_BAR;
    PG8_STAGE(PG8_SB(1, 0), cB + kstep, voffB); PG8_STAGE(PG8_SA(1, 0), cA + kstep, voffA); PG8_STAGE(PG8_SB(1, 1), cB + hB + kstep, voffB);
    PG8_WAIT_V(6); PG8_BAR;
    for (;;) {
        const bool has_next = S.next(ui + 1, nxt);
        const char* nA = has_next ? (const char*)g.A + (size_t)nxt.pm * tA : cA; const char* nB = has_next ? (const char*)g.Bt + (size_t)nxt.pn * tB : cB;
        for (int t = 0; t < nt; t += 2) {
            const bool last = (t == nt - 2);
            const char* a1 = cA + (size_t)(t + 1) * kstep;
            const char* a2 = last ? nA : cA + (size_t)(t + 2) * kstep; const char* b2 = last ? nB : cB + (size_t)(t + 2) * kstep;
            const char* a3 = a2 + kstep; const char* b3 = b2 + kstep;
            PG8_LDB(B0, 0, 0); PG8_LDB(B1, 0, 1); PG8_SCHED; PG8_LDA(At, 0, 0); PG8_STAGE(PG8_SA(1, 1), a1 + hA, voffA);
            PG8_WAIT_V(8); PG8_WAIT_L(0); PG8_BAR; PG8_MMA(0, 0, At, B0); PG8_MMA(0, 1, At, B1); PG8_BAR; PG8_SCHED;
            PG8_LDA(At, 0, 1); PG8_STAGE(PG8_SB(0, 0), b2, voffB); PG8_STAGE(PG8_SB(0, 1), b2 + hB, voffB); PG8_STAGE(PG8_SA(0, 0), a2, voffA);
            PG8_WAIT_V(8); PG8_WAIT_L(0); PG8_BAR; PG8_MMA(1, 0, At, B0); PG8_MMA(1, 1, At, B1); PG8_BAR; PG8_SCHED;
            PG8_LDB(B0, 1, 0); PG8_LDB(B1, 1, 1); PG8_SCHED; PG8_LDA(At, 1, 0); PG8_STAGE(PG8_SA(0, 1), a2 + hA, voffA);
            PG8_WAIT_V(8); PG8_WAIT_L(0); PG8_BAR; PG8_MMA(0, 0, At, B0); PG8_MMA(0, 1, At, B1); PG8_BAR; PG8_SCHED;
            PG8_LDA(At, 1, 1); PG8_STAGE(PG8_SB(1, 0), b3, voffB); PG8_STAGE(PG8_SB(1, 1), b3 + hB, voffB); PG8_STAGE(PG8_SA(1, 0), a3, voffA);
            PG8_WAIT_V(8); PG8_WAIT_L(0); PG8_BAR; PG8_MMA(1, 0, At, B0); PG8_MMA(1, 1, At, B1); PG8_BAR; PG8_SCHED;
        }
        if (wr == 0) PG8_BAR;
        E(acc, cur, wr, wc, fr, fq);
        if (!has_next) break;
#pragma unroll
        for (int a = 0; a < 2; ++a)
#pragma unroll
            for (int b = 0; b < 2; ++b)
#pragma unroll
                for (int m = 0; m < 4; ++m)
#pragma unroll
                    for (int n = 0; n < 2; ++n) acc[a][b][m][n] = (f32x4){0.f, 0.f, 0.f, 0.f};
        cur = nxt; cA = nA; cB = nB; ++ui;
        if (wr == 1) PG8_BAR;
    }
    PG8_WAIT_V(0);
    PG8_BAR;
#undef PG8_SA
#undef PG8_SB
#undef PG8_STAGE
#undef PG8_LDA
#undef PG8_LDB
#undef PG8_MMA
#undef PG8_WAIT_V
#undef PG8_WAIT_L
#undef PG8_BAR
#undef PG8_SCHED
}
}

namespace att {
constexpr int NW = 8, QBLK = 32, KVBLK = 64;
constexpr float SCALE = 0.10206207261596575f;
constexpr float THR = 8.f;
constexpr size_t SHM_V = KVBLK * 128 * 2, SHM_K = KVBLK * 128 * 2;
#define KSWZ(row, colB) ((row) * 256 + ((colB) ^ (((row) & 15) << 4)))
#define SBAR() __builtin_amdgcn_sched_barrier(0)
__device__ __forceinline__ int crow(int r, int hi) { return (r & 3) + 8 * (r >> 2) + 4 * hi; }
__device__ __forceinline__ unsigned cvtpk(float lo, float hi) { unsigned r; asm volatile("v_cvt_pk_bf16_f32 %0, %1, %2" : "=v"(r) : "v"(lo), "v"(hi)); return r; }

constexpr float THRL = THR * 1.4426950408889634f;
__device__ __forceinline__ void partialSM(f32x16& p0, f32x16& p1, float& mhat, f32x16& negm, float& alpha) {
    float pmax = p0[0];
#pragma unroll
    for (int r = 1; r < 16; ++r) pmax = fmaxf(pmax, p0[r]);
#pragma unroll
    for (int r = 0; r < 16; ++r) pmax = fmaxf(pmax, p1[r]);
    { auto rr = __builtin_amdgcn_permlane32_swap(__float_as_uint(pmax), __float_as_uint(pmax), false, false);
      pmax = fmaxf(__uint_as_float(rr[0]), __uint_as_float(rr[1])); }
    if (__builtin_expect(__all(pmax <= THRL), 1)) { alpha = 1.f; }
    else { const float dl = fmaxf(pmax, 0.f); mhat += dl;
#pragma unroll
        for (int r = 0; r < 16; ++r) { p0[r] -= dl; p1[r] -= dl; }
#pragma unroll
        for (int r = 0; r < 16; ++r) negm[r] = -mhat;
        alpha = __builtin_amdgcn_exp2f(-dl); }
    asm volatile("" : "+v"(negm));
#pragma unroll
    for (int r = 0; r < 16; ++r) p0[r] = __builtin_amdgcn_exp2f(p0[r]);
}
__device__ __forceinline__ void finishSM(f32x16& p0, f32x16& p1, float alpha, float& l_reg, bf16x8& pa0, bf16x8& pa1, bf16x8& pa2, bf16x8& pa3) {
#pragma unroll
    for (int r = 0; r < 16; ++r) p1[r] = __builtin_amdgcn_exp2f(p1[r]);
    float ps, psa = 0, psb = 0, psc = 0, psd = 0;
#pragma unroll
    for (int r = 0; r < 16; r += 4) { psa += p0[r]; psb += p0[r + 1]; psc += p0[r + 2]; psd += p0[r + 3]; }
#pragma unroll
    for (int r = 0; r < 16; r += 4) { psa += p1[r]; psb += p1[r + 1]; psc += p1[r + 2]; psd += p1[r + 3]; }
    ps = (psa + psb) + (psc + psd);
    { auto rr = __builtin_amdgcn_permlane32_swap(__float_as_uint(ps), __float_as_uint(ps), false, false);
      ps = __uint_as_float(rr[0]) + __uint_as_float(rr[1]); }
    l_reg = l_reg * alpha + ps;
#define PK4(P, BASE, OUT) do { unsigned a0 = cvtpk(P[BASE + 0], P[BASE + 1]), a1 = cvtpk(P[BASE + 2], P[BASE + 3]);   \
    unsigned b0 = cvtpk(P[BASE + 4], P[BASE + 5]), b1 = cvtpk(P[BASE + 6], P[BASE + 7]);                              \
    auto r0 = __builtin_amdgcn_permlane32_swap(a0, b0, false, false); auto r1 = __builtin_amdgcn_permlane32_swap(a1, b1, false, false); \
    u32x4 w = {r0[0], r1[0], r0[1], r1[1]}; OUT = *reinterpret_cast<bf16x8*>(&w); } while (0)
    PK4(p0, 0, pa0); PK4(p0, 8, pa1); PK4(p1, 0, pa2); PK4(p1, 8, pa3);
#undef PK4
}
__device__ __forceinline__ void qkt(f32x16& p0, f32x16& p1, const char* Ks, const bf16x8* qr, const f32x16& negm, int r32, int hi) {
#pragma unroll
    for (int d0 = 0; d0 < 6; ++d0) { int cb = (d0 * 16 + hi * 8) * 2;
        bf16x8 b0 = *reinterpret_cast<const bf16x8*>(Ks + KSWZ(r32, cb));
        bf16x8 b1 = *reinterpret_cast<const bf16x8*>(Ks + KSWZ(32 + r32, cb));
        if (d0 == 0) { p0 = __builtin_amdgcn_mfma_f32_32x32x16_bf16(b0, qr[0], negm, 0, 0, 0); p1 = __builtin_amdgcn_mfma_f32_32x32x16_bf16(b1, qr[0], negm, 0, 0, 0); }
        else { p0 = __builtin_amdgcn_mfma_f32_32x32x16_bf16(b0, qr[d0], p0, 0, 0, 0); p1 = __builtin_amdgcn_mfma_f32_32x32x16_bf16(b1, qr[d0], p1, 0, 0, 0); } }
}
__device__ __forceinline__ int v_st(int k, int c) { const int kk = (k & ~0xC) | ((k & 4) << 1) | ((k & 8) >> 1); return ((kk >> 3) * 4 + (c >> 5)) * 512 + ((kk & 7) * 32 + (c & 31)) * 2; }
__device__ __forceinline__ int v_rd_base(int lane) { return ((lane & 3) << 3) | (((lane >> 2) & 3) << 6) | (((lane >> 4) & 1) << 5) | (((lane >> 5) & 1) << 8); }
constexpr int v_rd_off(int d0, int ks, int half) { return d0 * 512 + ks * 4096 + half * 2048; }
template <int OFF> __device__ __forceinline__ s16x4 tr_read(int vb) {
    s16x4 r; asm volatile("ds_read_b64_tr_b16 %0, %1 offset:%2" : "=&v"(r) : "v"(vb), "i"(OFF) : "memory"); return r;
}
template <int D0> __device__ __forceinline__ void pv_one(f32x16& od, int vb, bf16x8 pa0, bf16x8 pa1, bf16x8 pa2, bf16x8 pa3) {
    const s16x4 l0 = tr_read<v_rd_off(D0, 0, 0)>(vb), h0 = tr_read<v_rd_off(D0, 0, 1)>(vb), l1 = tr_read<v_rd_off(D0, 1, 0)>(vb), h1 = tr_read<v_rd_off(D0, 1, 1)>(vb);
    const s16x4 l2 = tr_read<v_rd_off(D0, 2, 0)>(vb), h2 = tr_read<v_rd_off(D0, 2, 1)>(vb), l3 = tr_read<v_rd_off(D0, 3, 0)>(vb), h3 = tr_read<v_rd_off(D0, 3, 1)>(vb);
    asm volatile("s_waitcnt lgkmcnt(0)" ::: "memory"); SBAR();
#define PK(L, H) (bf16x8){L[0], L[1], L[2], L[3], H[0], H[1], H[2], H[3]}
    od = __builtin_amdgcn_mfma_f32_32x32x16_bf16(pa0, PK(l0, h0), od, 0, 0, 0);
    od = __builtin_amdgcn_mfma_f32_32x32x16_bf16(pa1, PK(l1, h1), od, 0, 0, 0);
    od = __builtin_amdgcn_mfma_f32_32x32x16_bf16(pa2, PK(l2, h2), od, 0, 0, 0);
    od = __builtin_amdgcn_mfma_f32_32x32x16_bf16(pa3, PK(l3, h3), od, 0, 0, 0);
#undef PK
}
__device__ __forceinline__ void pv_d0(f32x16* o, int vb, bf16x8 pa0, bf16x8 pa1, bf16x8 pa2, bf16x8 pa3) {
    pv_one<0>(o[0], vb, pa0, pa1, pa2, pa3); pv_one<1>(o[1], vb, pa0, pa1, pa2, pa3);
}

__device__ __forceinline__ void attn_body(const bf16_t* Qb, const bf16_t* __restrict__ Kh, const bf16_t* __restrict__ Vh, bf16_t* Ob, int seq, char* lds) {
    int tid = threadIdx.x; asm volatile("" : "+v"(tid));
    const int wid = tid >> 6, lane = tid & 63, r32 = lane & 31, hi = lane >> 5;
    char* V_lds = lds; char* K_lds = lds + 2 * SHM_V;
    float* ws = (float*)(lds + 2 * SHM_V + 2 * SHM_K) + wid * 64; float* li_l = ws; float* al_l = ws + 32;
    float mhat = 0.f, l_reg = 0; f32x16 o[2] = {}; bf16x8 qr[6]; f32x16 negm = f32x16{}; asm volatile("" : "+v"(negm));
    const bf16_t* Qw = Qb + (long)(wid * QBLK + r32) * LDQ + hi * 8;
#pragma unroll
    for (int d0 = 0; d0 < 6; ++d0) qr[d0] = *reinterpret_cast<const bf16x8*>(Qw + d0 * 16);
    const int kc0 = tid, kc1 = (tid < 256) ? 512 + tid : tid;
    const int kr0 = kc0 / 12, kcc0 = kc0 % 12, kr1 = kc1 / 12, kcc1 = kc1 % 12;
    const bool k1ok = tid < 256;
    const int vr = tid >> 3, vc = (tid & 7) * 8;
    const int kst0 = KSWZ(kr0, kcc0 * 16), kst1 = KSWZ(kr1, kcc1 * 16), vst = v_st(vr, vc);
    const int vb0 = (int)(uintptr_t)V_lds + v_rd_base(lane);
    struct { bf16x8 v, k0, k1; } sr_[2];
#define SLOAD(i, kk0) do { sr_[i].v = *reinterpret_cast<const bf16x8*>(&Vh[(long)((kk0) + vr) * LDKV + vc]); \
    sr_[i].k0 = *reinterpret_cast<const bf16x8*>(&Kh[(long)((kk0) + kr0) * LDKV + kcc0 * 8]); \
    sr_[i].k1 = *reinterpret_cast<const bf16x8*>(&Kh[(long)((kk0) + kr1) * LDKV + kcc1 * 8]); } while (0)
#define SWRITE(b, i) do { *(bf16x8*)(V_lds + (b) * SHM_V + vst) = sr_[i].v; \
    *(bf16x8*)(K_lds + (b) * SHM_K + kst0) = sr_[i].k0; \
    if (k1ok) *(bf16x8*)(K_lds + (b) * SHM_K + kst1) = sr_[i].k1; } while (0)
#define SWAIT() asm volatile("s_waitcnt vmcnt(3)" ::: "memory")
#define RESC(a) do { if (__any((a) < 1.f)) { if (hi == 0) al_l[r32] = (a); asm volatile("s_waitcnt lgkmcnt(0)" ::: "memory"); \
    _Pragma("unroll") for (int d = 0; d < 2; ++d) _Pragma("unroll") for (int r = 0; r < 16; ++r) o[d][r] *= al_l[crow(r, hi)]; } } while (0)
    f32x16 pA0, pA1, pB0, pB1; float alA, alB; bf16x8 pa0, pa1, pa2, pa3; const int NT = seq / KVBLK;
    constexpr int SE = 0, SO = 1;
    SLOAD(SE, 0); asm volatile("s_waitcnt vmcnt(0)" ::: "memory"); SWRITE(0, SE); __syncthreads();
    qkt(pA0, pA1, K_lds, qr, negm, r32, hi); partialSM(pA0, pA1, mhat, negm, alA);
    SLOAD(SO, KVBLK); SLOAD(SE, 2 * KVBLK);
    SWAIT(); SWRITE(1, SO); __syncthreads();
    for (int j = 1; j + 1 < NT; j += 2) {
        SBAR(); qkt(pB0, pB1, K_lds + SHM_K, qr, negm, r32, hi);
        finishSM(pA0, pA1, alA, l_reg, pa0, pa1, pa2, pa3); SBAR();
        SLOAD(SO, (j + 2) * KVBLK); SBAR();
        pv_d0(o, vb0, pa0, pa1, pa2, pa3); partialSM(pB0, pB1, mhat, negm, alB);
        __syncthreads(); SWAIT(); SWRITE(0, SE);
        RESC(alB); __syncthreads();
        SBAR(); qkt(pA0, pA1, K_lds, qr, negm, r32, hi);
        finishSM(pB0, pB1, alB, l_reg, pa0, pa1, pa2, pa3); SBAR();
        { const int jn = (j + 3 < NT) ? (j + 3) : (NT - 1); SLOAD(SE, jn * KVBLK); } SBAR();
        pv_d0(o, vb0 + (int)SHM_V, pa0, pa1, pa2, pa3); partialSM(pA0, pA1, mhat, negm, alA);
        __syncthreads(); SWAIT(); SWRITE(1, SO);
        RESC(alA); __syncthreads();
    }
    SBAR(); qkt(pB0, pB1, K_lds + SHM_K, qr, negm, r32, hi);
    finishSM(pA0, pA1, alA, l_reg, pa0, pa1, pa2, pa3); SBAR();
    pv_d0(o, vb0, pa0, pa1, pa2, pa3); partialSM(pB0, pB1, mhat, negm, alB);
    __syncthreads(); RESC(alB);
    finishSM(pB0, pB1, alB, l_reg, pa0, pa1, pa2, pa3); SBAR();
    pv_d0(o, vb0 + (int)SHM_V, pa0, pa1, pa2, pa3);
    if (hi == 0) li_l[r32] = l_reg; asm volatile("s_waitcnt lgkmcnt(0)" ::: "memory");
    float rli[16];
#pragma unroll
    for (int r = 0; r < 16; ++r) rli[r] = __builtin_amdgcn_rcpf(li_l[crow(r, hi)]);
    bf16_t* Ow = Ob + (long)(wid * QBLK) * LDQ;
#pragma unroll
    for (int r = 0; r < 16; ++r) { int orow = crow(r, hi);
#pragma unroll
        for (int d0 = 0; d0 < 2; ++d0) Ow[(long)orow * LDQ + d0 * 32 + r32] = f2bf(o[d0][r] * rli[r]); }
#undef SLOAD
#undef SWRITE
#undef SWAIT
#undef RESC
}

__device__ __forceinline__ void partialSM_abs(f32x16& p0, f32x16& p1, float& mhat, float& alpha) {
    float pmax = p0[0], pmb = p1[0];
#pragma unroll
    for (int r = 1; r < 16; ++r) { pmax = fmaxf(pmax, p0[r]); pmb = fmaxf(pmb, p1[r]); }
    pmax = fmaxf(pmax, pmb);
    { auto rr = __builtin_amdgcn_permlane32_swap(__float_as_uint(pmax), __float_as_uint(pmax), false, false);
      pmax = fmaxf(__uint_as_float(rr[0]), __uint_as_float(rr[1])); }
    alpha = 1.f;
    if (__builtin_expect(!__all((pmax - mhat <= THRL) && (mhat == 0.f)), 0)) {
        const float rel = pmax - mhat;
        if (rel > THRL) { mhat += rel; alpha = __builtin_amdgcn_exp2f(-rel); }
#pragma unroll
        for (int r = 0; r < 16; ++r) { p0[r] -= mhat; p1[r] -= mhat; }
    }
#pragma unroll
    for (int r = 0; r < 16; ++r) p0[r] = __builtin_amdgcn_exp2f(p0[r]);
}
constexpr int PP_LDS = 3 * (int)SHM_K + 3 * (int)SHM_V + 8 * 64 * 4;
__device__ __forceinline__ void attn_pp(const bf16_t* Qb, const bf16_t* __restrict__ Kh, const bf16_t* __restrict__ Vh, bf16_t* Ob, const int ldo, int seq, char* lds) {
    int tid = threadIdx.x; asm volatile("" : "+v"(tid));
    const int wid = tid >> 6, lane = tid & 63, r32 = lane & 31, hi = lane >> 5;
    const int half = __builtin_amdgcn_readfirstlane(wid >> 2);
    char* K_lds = lds; char* V_lds = lds + 3 * SHM_K;
    float* ws = (float*)(lds + 3 * SHM_K + 3 * SHM_V) + wid * 64; float* li_l = ws; float* al_l = ws + 32;
    float mhat = 0.f, l_reg = 0; f32x16 o[2] = {}; bf16x8 qr[6];
    const bf16_t* Qw = Qb + (long)(wid * QBLK + r32) * LDQ + hi * 8;
#pragma unroll
    for (int d0 = 0; d0 < 6; ++d0) qr[d0] = *reinterpret_cast<const bf16x8*>(Qw + d0 * 16);
    const int kc0 = tid, kc1 = (tid < 256) ? 512 + tid : tid;
    const int kr0 = kc0 / 12, kcc0 = kc0 % 12, kr1 = kc1 / 12, kcc1 = kc1 % 12;
    const bool k1ok = tid < 256;
    const int vr = tid >> 3, vc = (tid & 7) * 8;
    const int kst0 = KSWZ(kr0, kcc0 * 16), kst1 = KSWZ(kr1, kcc1 * 16), vst = v_st(vr, vc);
    const int vb0 = (int)(uintptr_t)V_lds + v_rd_base(lane);
    bf16x8 gk0, gk1, gv;
    bf16x8 kf[12];
    s16x4 vl[2][4], vh[2][4];
#define KREAD(slot) do { const char* Ks_ = K_lds + (slot) * (int)SHM_K; _Pragma("unroll") for (int d0 = 0; d0 < 6; ++d0) { const int cb = (d0 * 16 + hi * 8) * 2; \
    kf[2 * d0] = *reinterpret_cast<const bf16x8*>(Ks_ + KSWZ(r32, cb)); kf[2 * d0 + 1] = *reinterpret_cast<const bf16x8*>(Ks_ + KSWZ(32 + r32, cb)); } } while (0)
#define VISSUE0(vb_) do { const int vb__ = (vb_); \
    vl[0][0] = tr_read<v_rd_off(0, 0, 0)>(vb__); vh[0][0] = tr_read<v_rd_off(0, 0, 1)>(vb__); vl[0][1] = tr_read<v_rd_off(0, 1, 0)>(vb__); vh[0][1] = tr_read<v_rd_off(0, 1, 1)>(vb__); \
    vl[0][2] = tr_read<v_rd_off(0, 2, 0)>(vb__); vh[0][2] = tr_read<v_rd_off(0, 2, 1)>(vb__); vl[0][3] = tr_read<v_rd_off(0, 3, 0)>(vb__); vh[0][3] = tr_read<v_rd_off(0, 3, 1)>(vb__); } while (0)
#define VISSUE1(vb_) do { const int vb__ = (vb_); \
    vl[1][0] = tr_read<v_rd_off(1, 0, 0)>(vb__); vh[1][0] = tr_read<v_rd_off(1, 0, 1)>(vb__); vl[1][1] = tr_read<v_rd_off(1, 1, 0)>(vb__); vh[1][1] = tr_read<v_rd_off(1, 1, 1)>(vb__); \
    vl[1][2] = tr_read<v_rd_off(1, 2, 0)>(vb__); vh[1][2] = tr_read<v_rd_off(1, 2, 1)>(vb__); vl[1][3] = tr_read<v_rd_off(1, 3, 0)>(vb__); vh[1][3] = tr_read<v_rd_off(1, 3, 1)>(vb__); } while (0)
#define VPK(d, k) (bf16x8){vl[d][k][0], vl[d][k][1], vl[d][k][2], vl[d][k][3], vh[d][k][0], vh[d][k][1], vh[d][k][2], vh[d][k][3]}
#define PVMMA0() do { asm volatile("s_waitcnt lgkmcnt(8)" ::: "memory"); SBAR(); \
    o[0] = __builtin_amdgcn_mfma_f32_32x32x16_bf16(pa0, VPK(0, 0), o[0], 0, 0, 0); o[0] = __builtin_amdgcn_mfma_f32_32x32x16_bf16(pa1, VPK(0, 1), o[0], 0, 0, 0); \
    o[0] = __builtin_amdgcn_mfma_f32_32x32x16_bf16(pa2, VPK(0, 2), o[0], 0, 0, 0); o[0] = __builtin_amdgcn_mfma_f32_32x32x16_bf16(pa3, VPK(0, 3), o[0], 0, 0, 0); SBAR(); } while (0)
#define PVMMA1() do { asm volatile("s_waitcnt lgkmcnt(0)" ::: "memory"); SBAR(); \
    o[1] = __builtin_amdgcn_mfma_f32_32x32x16_bf16(pa0, VPK(1, 0), o[1], 0, 0, 0); o[1] = __builtin_amdgcn_mfma_f32_32x32x16_bf16(pa1, VPK(1, 1), o[1], 0, 0, 0); \
    o[1] = __builtin_amdgcn_mfma_f32_32x32x16_bf16(pa2, VPK(1, 2), o[1], 0, 0, 0); o[1] = __builtin_amdgcn_mfma_f32_32x32x16_bf16(pa3, VPK(1, 3), o[1], 0, 0, 0); } while (0)
#define QKREG(D0A, D0B) do { _Pragma("unroll") for (int d0 = (D0A); d0 < (D0B); ++d0) { p0 = __builtin_amdgcn_mfma_f32_32x32x16_bf16(kf[2 * d0], qr[d0], p0, 0, 0, 0); p1 = __builtin_amdgcn_mfma_f32_32x32x16_bf16(kf[2 * d0 + 1], qr[d0], p1, 0, 0, 0); } } while (0)
#define LOADK(kk0) do { gk0 = *reinterpret_cast<const bf16x8*>(&Kh[(long)((kk0) + kr0) * LDKV + kcc0 * 8]); gk1 = *reinterpret_cast<const bf16x8*>(&Kh[(long)((kk0) + kr1) * LDKV + kcc1 * 8]); } while (0)
#define LOADV(kk0) do { gv = *reinterpret_cast<const bf16x8*>(&Vh[(long)((kk0) + vr) * LDKV + vc]); } while (0)
#define WRITEK(slot) do { *(bf16x8*)(K_lds + (slot) * (int)SHM_K + kst0) = gk0; if (k1ok) *(bf16x8*)(K_lds + (slot) * (int)SHM_K + kst1) = gk1; } while (0)
#define WRITEV(slot) do { *(bf16x8*)(V_lds + (slot) * (int)SHM_V + vst) = gv; } while (0)
#define BARRIER() do { asm volatile("s_waitcnt lgkmcnt(0)" ::: "memory"); __builtin_amdgcn_s_barrier(); asm volatile("" ::: "memory"); SBAR(); } while (0)
#define RESC(a) do { if (__any((a) < 1.f)) { if (hi == 0) al_l[r32] = (a); asm volatile("s_waitcnt lgkmcnt(0)" ::: "memory"); \
    _Pragma("unroll") for (int d = 0; d < 2; ++d) _Pragma("unroll") for (int r = 0; r < 16; ++r) o[d][r] *= al_l[crow(r, hi)]; } } while (0)
    const int NT = seq / KVBLK;
    LOADK(0); asm volatile("s_waitcnt vmcnt(0)" ::: "memory"); WRITEK(0);
    LOADK(KVBLK); asm volatile("s_waitcnt vmcnt(0)" ::: "memory"); WRITEK(1);
    BARRIER();
    KREAD(0);
    LOADK(2 * KVBLK); LOADV(0);
    if (half == 1) BARRIER();
    f32x16 p0, p1; float alpha; bf16x8 pa0, pa1, pa2, pa3;
    int s0 = 0, s1 = 1, s2 = 2;
    for (int i = 0; i < NT; ++i) {
        if (i > 0) VISSUE0(vb0 + s2 * (int)SHM_V);
        SBAR();
        p0 = f32x16{}; p1 = f32x16{};
        QKREG(0, 3);
        SBAR();
        if (i > 0) VISSUE1(vb0 + s2 * (int)SHM_V);
        SBAR();
        QKREG(3, 6);
        SBAR();
        if (i > 0) { PVMMA0(); PVMMA1(); }
        asm volatile("s_waitcnt vmcnt(0)" ::: "memory");
        WRITEK(s2); WRITEV(s0);
        BARRIER();
        if (i + 1 < NT) KREAD(s1);
        { const int tk = (i + 3 < NT) ? i + 3 : NT - 1, tv = (i + 1 < NT) ? i + 1 : NT - 1; LOADK(tk * KVBLK); LOADV(tv * KVBLK); }
        partialSM_abs(p0, p1, mhat, alpha);
        finishSM(p0, p1, alpha, l_reg, pa0, pa1, pa2, pa3);
        RESC(alpha);
        BARRIER();
        { const int t = s0; s0 = s1; s1 = s2; s2 = t; }
    }
    VISSUE0(vb0 + s2 * (int)SHM_V); VISSUE1(vb0 + s2 * (int)SHM_V); PVMMA0(); PVMMA1();
    BARRIER();
    if (half == 0) BARRIER();
    if (hi == 0) li_l[r32] = l_reg; asm volatile("s_waitcnt lgkmcnt(0)" ::: "memory");
    float rli[16];
#pragma unroll
    for (int r = 0; r < 16; ++r) rli[r] = __builtin_amdgcn_rcpf(li_l[crow(r, hi)]);
    bf16_t* Ow = Ob + (long)(wid * QBLK) * ldo;
#pragma unroll
    for (int r = 0; r < 16; ++r) { int orow = crow(r, hi);
#pragma unroll
        for (int d0 = 0; d0 < 2; ++d0) Ow[(long)orow * ldo + d0 * 32 + r32] = f2bf(o[d0][r] * rli[r]); }
#undef KREAD
#undef VISSUE0
#undef VISSUE1
#undef VPK
#undef PVMMA0
#undef PVMMA1
#undef QKREG
#undef LOADK
#undef LOADV
#undef WRITEK
#undef WRITEV
#undef BARRIER
#undef RESC
}
#undef KSWZ
#undef SBAR
}

__device__ __forceinline__ float wsrc(const Args& a, int mat, int l, int k, int n) {
    switch (mat) {
    case 0: { const int s = (n < 416) ? n : ((n < 512) ? -1 : n - 96);
              return s < 0 ? 0.f : a.in[2][((size_t)l * DM + k) * INC + s] * a.in[1][l * DM + k]; }
    case 1: return a.in[4][((size_t)l * 256 + k) * 768 + n] * a.in[3][l * 256 + k];
    case 2: { const float g = a.in[5][l * 128 + k];
              if (n < 768) { const int h = n / 96, j = n % 96; return j < 64 ? a.in[6][((size_t)l * 128 + k) * 512 + h * 64 + j] * g : 0.f; }
              return a.in[7][((size_t)l * 128 + k) * 512 + (n - 768)] * g; }
    case 3: return a.in[10][((size_t)l * 512 + k) * 1024 + n];
    case 4: { const int s = ((n >> 2) & 1) * 1024 + (n >> 3) * 4 + (n & 3); return a.in[19][((size_t)l * 512 + k) * 2048 + s]; }
    case 5: return a.in[20][((size_t)l * 1024 + k) * 1024 + n];
    case 6: { const int j = (n >> 3) * 4 + (n & 3); const float* w = ((n >> 2) & 1) ? a.in[23] : a.in[22];
              return w[((size_t)l * 1024 + k) * DFF + j] * a.in[21][l * 1024 + k]; }
    default: return a.in[24][((size_t)l * DFF + k) * 1024 + n];
    }
}
__device__ __forceinline__ void transpose_item(const Args& a, int mat, int l, int Kd, int Nd, bf16_t* WT, LAS float* scr, int item, int lane) {
    const int nblk = Nd / 32, kb = item / nblk, nb = item % nblk, k0 = 64 * kb, n0 = 32 * nb;
    float tv[32];
#pragma unroll
    for (int i = 0; i < 32; ++i) tv[i] = wsrc(a, mat, l, k0 + 2 * i + (lane >> 5), n0 + (lane & 31));
#pragma unroll
    for (int i = 0; i < 32; ++i) scr[(2 * i + (lane >> 5)) * 33 + (lane & 31)] = tv[i];
    asm volatile("s_waitcnt lgkmcnt(0)" ::: "memory");
    const int c = lane & 7;
#pragma unroll
    for (int j = 0; j < 4; ++j) { const int n = (lane >> 3) + 8 * j; const LAS float* s = scr + (8 * c) * 33 + n;
        u32x4 o; o.x = cvt_pk_bf16(s[0 * 33], s[1 * 33]); o.y = cvt_pk_bf16(s[2 * 33], s[3 * 33]); o.z = cvt_pk_bf16(s[4 * 33], s[5 * 33]); o.w = cvt_pk_bf16(s[6 * 33], s[7 * 33]);
        *(u32x4*)(WT + (size_t)(n0 + n) * Kd + k0 + 8 * c) = o; }
    asm volatile("s_waitcnt lgkmcnt(0)" ::: "memory");
}
__device__ __forceinline__ void p0_prologue(const Args& a, LAS unsigned char* lds, int gw, int NGW, int wave, int lane) {
    LAS float* scr = (LAS float*)(lds + wave * 16384);
    constexpr int KD[8] = {1024, 256, 128, 512, 512, 1024, 1024, 2816};
    constexpr int ND[8] = {3072, 768, 1280, 1024, 2048, 1024, 5632, 1024};
    constexpr size_t WO[8] = {W0, W1, W2, W3, W4, W5, W6, W7};
    constexpr int IT[8] = {16 * 96, 4 * 24, 2 * 40, 8 * 32, 8 * 64, 16 * 32, 16 * 176, 44 * 32};
    constexpr int ITL = IT[0] + IT[1] + IT[2] + IT[3] + IT[4] + IT[5] + IT[6] + IT[7];
    for (int it = gw; it < DEPTH * ITL; it += NGW) {
        const int l = it / ITL; int r = it % ITL;
#pragma unroll
        for (int mt = 0; mt < 8; ++mt) {
            if (r >= 0 && r < IT[mt]) transpose_item(a, mt, l, KD[mt], ND[mt], (bf16_t*)(a.ws + WS_W + (size_t)l * W_LAYER + WO[mt]), scr, r, lane);
            r -= IT[mt];
        }
    }
    const int gt = gw * 64 + lane;
    if (gt < DEPTH * 2 * NG * ST) {
        const int ldg = gt / ST;
        const float lre = a.in[11][gt], lim = a.in[12][gt];
        const float dt = expf(a.in[13][ldg]);
        const float ar = lre * dt, ai = lim * dt;
        const float ea = expf(ar), cb = cosf(ai), sb = sinf(ai), sh = sinf(0.5f * ai);
        const float lbr = ea * cb, lbi = ea * sb;
        const float nr = expm1f(ar) * cb - 2.f * sh * sh, ni = ea * sb;
        const float den = 1.f / (lre * lre + lim * lim);
        const float cr = (nr * lre + ni * lim) * den, ci = (ni * lre - nr * lim) * den;
        ((f32x2*)(a.ws + WS_LAMB))[gt] = (f32x2){lbr, lbi};
        f32x2* bb = (f32x2*)(a.ws + WS_BBAR) + (size_t)gt * 16;
#pragma unroll
        for (int c = 0; c < 16; ++c) { const float br = a.in[14][(size_t)gt * 16 + c], bi = a.in[15][(size_t)gt * 16 + c];
            bb[c] = (f32x2){cr * br - ci * bi, cr * bi + ci * br}; }
    }
}

__device__ __forceinline__ void norm_row2(const float* xa, bf16_t* oa, const float* xb, bf16_t* ob, int lane) {
    const f32x4* ra = (const f32x4*)xa + lane; const f32x4* rb = (const f32x4*)xb + lane;
    f32x4 va[4], vb[4]; float sa = 0.f, sb = 0.f;
#pragma unroll
    for (int j = 0; j < 4; ++j) { va[j] = ra[64 * j]; vb[j] = rb[64 * j]; }
#pragma unroll
    for (int j = 0; j < 4; ++j) { sa += (va[j].x * va[j].x + va[j].y * va[j].y) + (va[j].z * va[j].z + va[j].w * va[j].w); sb += (vb[j].x * vb[j].x + vb[j].y * vb[j].y) + (vb[j].z * vb[j].z + vb[j].w * vb[j].w); }
#pragma unroll
    for (int o = 1; o < 64; o <<= 1) { sa += __shfl_xor(sa, o); sb += __shfl_xor(sb, o); }
    const float ia = 1.f / sqrtf(sa * (1.f / DM) + EPS), ib = 1.f / sqrtf(sb * (1.f / DM) + EPS);
    u32x2* pa = (u32x2*)oa + lane; u32x2* pb = (u32x2*)ob + lane;
#pragma unroll
    for (int j = 0; j < 4; ++j) { u32x2 w; w.x = cvt_pk_bf16(va[j].x * ia, va[j].y * ia); w.y = cvt_pk_bf16(va[j].z * ia, va[j].w * ia); pa[64 * j] = w;
        u32x2 z; z.x = cvt_pk_bf16(vb[j].x * ib, vb[j].y * ib); z.y = cvt_pk_bf16(vb[j].z * ib, vb[j].w * ib); pb[64 * j] = z; }
}
__device__ __forceinline__ void norm_row(const float* xrow, bf16_t* orow, int lane) {
    const f32x4* xr = (const f32x4*)xrow + lane;
    f32x4 v[4]; float s = 0.f;
#pragma unroll
    for (int j = 0; j < 4; ++j) { v[j] = xr[64 * j]; s += (v[j].x * v[j].x + v[j].y * v[j].y) + (v[j].z * v[j].z + v[j].w * v[j].w); }
    const float rinv = 1.f / sqrtf(wave_sum(s) * (1.f / DM) + EPS);
    u32x2* o8 = (u32x2*)orow + lane;
#pragma unroll
    for (int j = 0; j < 4; ++j) { u32x2 w; w.x = cvt_pk_bf16(v[j].x * rinv, v[j].y * rinv); w.y = cvt_pk_bf16(v[j].z * rinv, v[j].w * rinv); o8[64 * j] = w; }
}

__device__ __forceinline__ void sincos_d(double a, float& s, float& c) {
    const double TWO_OVER_PI = 0.63661977236758134308, PIO2_HI = 1.57079632679489655800e+00, PIO2_LO = 6.12323399573676603587e-17;
    const double kq = rint(a * TWO_OVER_PI);
    double y = fma(-kq, PIO2_HI, a); y = fma(-kq, PIO2_LO, y);
    const double y2 = y * y;
    double sp = 1.0 / 6227020800.0; sp = fma(sp, y2, -1.0 / 39916800.0); sp = fma(sp, y2, 1.0 / 362880.0); sp = fma(sp, y2, -1.0 / 5040.0); sp = fma(sp, y2, 1.0 / 120.0); sp = fma(sp, y2, -1.0 / 6.0); sp = fma(sp, y2, 1.0);
    const double sy = y * sp;
    double cp = 1.0 / 479001600.0; cp = fma(cp, y2, -1.0 / 3628800.0); cp = fma(cp, y2, 1.0 / 40320.0); cp = fma(cp, y2, -1.0 / 720.0); cp = fma(cp, y2, 1.0 / 24.0); cp = fma(cp, y2, -0.5); cp = fma(cp, y2, 1.0);
    const int q = ((int)kq) & 3;
    const double ss = (q == 0) ? sy : (q == 1) ? cp : (q == 2) ? -sy : -cp;
    const double cc = (q == 0) ? cp : (q == 1) ? -sy : (q == 2) ? -cp : sy;
    s = (float)ss; c = (float)cc;
}

__device__ __forceinline__ void unpack8(const u32x4 w, float* v) { v[0] = bf_lo(w.x); v[1] = bf_hi(w.x); v[2] = bf_lo(w.y); v[3] = bf_hi(w.y); v[4] = bf_lo(w.z); v[5] = bf_hi(w.z); v[6] = bf_lo(w.w); v[7] = bf_hi(w.w); }
__device__ __forceinline__ u32x4 pack8(const float* v) { u32x4 w; w.x = cvt_pk_bf16(v[0], v[1]); w.y = cvt_pk_bf16(v[2], v[3]); w.z = cvt_pk_bf16(v[4], v[5]); w.w = cvt_pk_bf16(v[6], v[7]); return w; }
__device__ __forceinline__ void postproc_row(const Args& a, int l, int row, int lane) {
    const bf16_t* P = (const bf16_t*)(a.ws + WS_PROJ) + (size_t)row * PROJ_N;
    bf16_t* Qr = (bf16_t*)(a.ws + WS_Q) + (size_t)row * LDQ; bf16_t* KVr = (bf16_t*)(a.ws + WS_KV) + (size_t)row * LDKV;
    const int sub = lane & 7, head = lane >> 3; const bool rp = sub < 2;
    const u32x2 cqw = *(const u32x2*)(P + lane * 4);
    const unsigned ckw = *(const unsigned*)(P + 256 + lane * 2);
    const u32x4 q0w = *(const u32x4*)(Qr + head * 96 + sub * 8);
    const u32x4 k0w = *(const u32x4*)(KVr + head * 96 + sub * 8);
    u32x4 q1w = {0, 0, 0, 0}, q2w = {0, 0, 0, 0}, r1w = {0, 0, 0, 0}, r2w = {0, 0, 0, 0};
    if (rp) { q1w = *(const u32x4*)(Qr + head * 96 + 64 + sub * 8); q2w = *(const u32x4*)(Qr + head * 96 + 80 + sub * 8);
              r1w = *(const u32x4*)(P + 384 + sub * 8); r2w = *(const u32x4*)(P + 384 + 16 + sub * 8); }
    u32x4* vp = (u32x4*)(KVr + 768 + lane * 8); const u32x4 vw = *vp;
    const f32x4 gq0a = *(const f32x4*)(a.in[8] + l * 96 + sub * 8), gq0b = *(const f32x4*)(a.in[8] + l * 96 + sub * 8 + 4);
    const f32x4 gk0a = *(const f32x4*)(a.in[9] + l * 96 + sub * 8), gk0b = *(const f32x4*)(a.in[9] + l * 96 + sub * 8 + 4);
    const int so = rp ? sub * 8 : 0;
    const f32x4 gq1a = *(const f32x4*)(a.in[8] + l * 96 + 64 + so), gq1b = *(const f32x4*)(a.in[8] + l * 96 + 64 + so + 4);
    const f32x4 gq2a = *(const f32x4*)(a.in[8] + l * 96 + 80 + so), gq2b = *(const f32x4*)(a.in[8] + l * 96 + 80 + so + 4);
    const f32x4 gk1a = *(const f32x4*)(a.in[9] + l * 96 + 64 + so), gk1b = *(const f32x4*)(a.in[9] + l * 96 + 64 + so + 4);
    const f32x4 gk2a = *(const f32x4*)(a.in[9] + l * 96 + 80 + so), gk2b = *(const f32x4*)(a.in[9] + l * 96 + 80 + so + 4);
    float s1 = bf_lo(cqw.x) * bf_lo(cqw.x) + bf_hi(cqw.x) * bf_hi(cqw.x) + bf_lo(cqw.y) * bf_lo(cqw.y) + bf_hi(cqw.y) * bf_hi(cqw.y);
    float s2 = bf_lo(ckw) * bf_lo(ckw) + bf_hi(ckw) * bf_hi(ckw);
#pragma unroll
    for (int o = 1; o < 64; o <<= 1) { s1 += __shfl_xor(s1, o); s2 += __shfl_xor(s2, o); }
    const float sq = 1.f / sqrtf(s1 * (1.f / 256.f) + EPS), skv = 1.f / sqrtf(s2 * (1.f / 128.f) + EPS);
    const int pos = row & (SEQ - 1);
    float cs[8], sn[8];
#pragma unroll
    for (int e = 0; e < 8; ++e) { cs[e] = 1.f; sn[e] = 0.f; }
    if (rp) {
#pragma unroll
        for (int e = 0; e < 8; ++e) { const int i3 = e & 3; const int i2 = sub * 2 + (e >> 2);
            const double base = (i3 == 0) ? 1.0 : (i3 == 1) ? 0.5623413251903491 : (i3 == 2) ? 0.31622776601683794 : 0.17782794100389228;
            const double sc = (i2 == 0) ? 1.0 : (i2 == 1) ? 0.1 : (i2 == 2) ? 0.01 : 0.001;
            const float invf = (float)(base * sc); const float ang = (float)pos * invf;
            sincos_d((double)ang, sn[e], cs[e]); } }
    float g0[8] = {gq0a.x, gq0a.y, gq0a.z, gq0a.w, gq0b.x, gq0b.y, gq0b.z, gq0b.w};
    float g1[8] = {gq1a.x, gq1a.y, gq1a.z, gq1a.w, gq1b.x, gq1b.y, gq1b.z, gq1b.w};
    float g2[8] = {gq2a.x, gq2a.y, gq2a.z, gq2a.w, gq2b.x, gq2b.y, gq2b.z, gq2b.w};
    { float v0[8], v1[8], v2[8]; unpack8(q0w, v0); unpack8(q1w, v1); unpack8(q2w, v2); float ss = 0.f;
#pragma unroll
      for (int e = 0; e < 8; ++e) { v0[e] *= sq; v1[e] *= sq; v2[e] *= sq; ss += v0[e] * v0[e] + v1[e] * v1[e] + v2[e] * v2[e]; }
      ss += __shfl_xor(ss, 1); ss += __shfl_xor(ss, 2); ss += __shfl_xor(ss, 4);
      const float rinv = 1.f / sqrtf(ss * (1.f / 96.f) + EPS) * (att::SCALE * 1.4426950408889634f);
#pragma unroll
      for (int e = 0; e < 8; ++e) { v0[e] *= rinv * g0[e]; const float x1 = v1[e] * rinv * g1[e], x2 = v2[e] * rinv * g2[e]; v1[e] = x1 * cs[e] - x2 * sn[e]; v2[e] = x2 * cs[e] + x1 * sn[e]; }
      *(u32x4*)(Qr + head * 96 + sub * 8) = pack8(v0);
      if (rp) { *(u32x4*)(Qr + head * 96 + 64 + sub * 8) = pack8(v1); *(u32x4*)(Qr + head * 96 + 80 + sub * 8) = pack8(v2); } }
    { float h0[8] = {gk0a.x, gk0a.y, gk0a.z, gk0a.w, gk0b.x, gk0b.y, gk0b.z, gk0b.w};
      float h1[8] = {gk1a.x, gk1a.y, gk1a.z, gk1a.w, gk1b.x, gk1b.y, gk1b.z, gk1b.w};
      float h2[8] = {gk2a.x, gk2a.y, gk2a.z, gk2a.w, gk2b.x, gk2b.y, gk2b.z, gk2b.w};
      float v0[8], v1[8], v2[8]; unpack8(k0w, v0); unpack8(r1w, v1); unpack8(r2w, v2); float ss = 0.f;
#pragma unroll
      for (int e = 0; e < 8; ++e) { v0[e] *= skv; ss += v0[e] * v0[e] + v1[e] * v1[e] + v2[e] * v2[e]; }
      ss += __shfl_xor(ss, 1); ss += __shfl_xor(ss, 2); ss += __shfl_xor(ss, 4);
      const float rinv = 1.f / sqrtf(ss * (1.f / 96.f) + EPS);
#pragma unroll
      for (int e = 0; e < 8; ++e) { v0[e] *= rinv * h0[e]; const float x1 = v1[e] * rinv * h1[e], x2 = v2[e] * rinv * h2[e]; v1[e] = x1 * cs[e] - x2 * sn[e]; v2[e] = x2 * cs[e] + x1 * sn[e]; }
      *(u32x4*)(KVr + head * 96 + sub * 8) = pack8(v0);
      if (rp) { *(u32x4*)(KVr + head * 96 + 64 + sub * 8) = pack8(v1); *(u32x4*)(KVr + head * 96 + 80 + sub * 8) = pack8(v2); } }
    { float v[8]; unpack8(vw, v);
#pragma unroll
      for (int e = 0; e < 8; ++e) v[e] *= skv;
      *vp = pack8(v); }
}

template <bool FULL, int DIR>
__device__ __forceinline__ void s5_dir(const Args& a, int l, int b, int g, int ch, int lane) {
    const bf16_t* PROJ = (const bf16_t*)(a.ws + WS_PROJ);
    const int ldg = (l * 2 + DIR) * NG + g, sidx = ldg * ST + lane;
    const f32x2 lam = ((const f32x2*)(a.ws + WS_LAMB))[sidx];
    float bre[16], bim[16];
    { const f32x4* bb = (const f32x4*)((const f32x2*)(a.ws + WS_BBAR) + (size_t)sidx * 16);
#pragma unroll
      for (int c2 = 0; c2 < 8; ++c2) { const f32x4 t = bb[c2]; bre[2 * c2] = t.x; bim[2 * c2] = t.y; bre[2 * c2 + 1] = t.z; bim[2 * c2 + 1] = t.w; } }
    float cre[16], cim[16];
    if (FULL) {
#pragma unroll
        for (int c = 0; c < 16; ++c) { cre[c] = a.in[16][((size_t)ldg * 16 + c) * ST + lane]; cim[c] = -a.in[17][((size_t)ldg * 16 + c) * ST + lane]; } }
    float sr = 0.f, si = 0.f;
    f32x2* E = (f32x2*)(a.ws + WS_E) + ((size_t)((b * NG + g) * 2 + DIR) * NCH) * ST + lane;
    if (FULL) {
        float pr = lam.x, pi = lam.y;
#pragma unroll
        for (int i = 0; i < 9; ++i) { const float t = pr * pr - pi * pi; pi = 2.f * pr * pi; pr = t; }
        if (DIR == 0) { for (int j = 0; j < ch; ++j) { const f32x2 e = E[(size_t)j * ST]; const float t = pr * sr - pi * si + e.x; si = pr * si + pi * sr + e.y; sr = t; } }
        else { for (int j = NCH - 1; j > ch; --j) { const f32x2 e = E[(size_t)j * ST]; const float t = pr * sr - pi * si + e.x; si = pr * si + pi * sr + e.y; sr = t; } }
    }
    const size_t row0 = (size_t)b * SEQ + (size_t)ch * CHUNK;
    for (int tile = 0; tile < CHUNK / 64; ++tile) {
        const int tt = (DIR == 0) ? tile : (CHUNK / 64 - 1 - tile);
        const size_t tok0 = row0 + (size_t)tt * 64;
        const u32x4* up = (const u32x4*)(PROJ + (tok0 + lane) * PROJ_N + 512 + g * 16);
        const u32x4 ua = up[0], ub = up[1];
        for (int t4 = 0; t4 < 16; ++t4) {
            float part[64];
#pragma unroll
            for (int q = 0; q < 4; ++q) {
                const int tl = t4 * 4 + q, tsel = (DIR == 0) ? tl : 63 - tl;
                unsigned w[8];
                w[0] = __builtin_amdgcn_readlane(ua.x, tsel); w[1] = __builtin_amdgcn_readlane(ua.y, tsel); w[2] = __builtin_amdgcn_readlane(ua.z, tsel); w[3] = __builtin_amdgcn_readlane(ua.w, tsel);
                w[4] = __builtin_amdgcn_readlane(ub.x, tsel); w[5] = __builtin_amdgcn_readlane(ub.y, tsel); w[6] = __builtin_amdgcn_readlane(ub.z, tsel); w[7] = __builtin_amdgcn_readlane(ub.w, tsel);
                float bur = 0.f, bui = 0.f;
#pragma unroll
                for (int c2 = 0; c2 < 8; ++c2) { const float u0 = bf_lo(w[c2]), u1 = bf_hi(w[c2]);
                    bur = fmaf(bre[2 * c2], u0, bur); bui = fmaf(bim[2 * c2], u0, bui); bur = fmaf(bre[2 * c2 + 1], u1, bur); bui = fmaf(bim[2 * c2 + 1], u1, bui); }
                const float nr = lam.x * sr - lam.y * si + bur, ni = lam.x * si + lam.y * sr + bui; sr = nr; si = ni;
                if (FULL) { constexpr int dummy = 0; (void)dummy; const int slot = (DIR == 0) ? q : 3 - q;
#pragma unroll
                    for (int c = 0; c < 16; ++c) part[slot * 16 + c] = cre[c] * sr + cim[c] * si; }
            }
            if (FULL) {
#define RSTEP(NK, XM) { const bool upb = (lane & XM) != 0; _Pragma("unroll") for (int i = 0; i < NK; ++i) { const float keep = upb ? part[i + NK] : part[i]; const float send = upb ? part[i] : part[i + NK]; part[i] = keep + __shfl_xor(send, XM); } }
                RSTEP(32, 32) RSTEP(16, 16) RSTEP(8, 8) RSTEP(4, 4) RSTEP(2, 2) RSTEP(1, 1)
#undef RSTEP
                const int tb = (DIR == 0) ? t4 * 4 : 60 - t4 * 4;
                const size_t row = tok0 + tb + (lane >> 4); const int c = lane & 15;
                float* yf = (float*)(a.ws + WS_YF) + row * 512 + g * 16 + c;
                if (DIR == 0) { *yf = part[0]; }
                else { const float u = bf2f(PROJ[row * PROJ_N + 512 + g * 16 + c]);
                    const float y = part[0] + *yf + a.in[18][l * 512 + g * 16 + c] * u;
                    const float z2 = 1.5957691216057308f * (y + 0.044715f * y * y * y);
                    const float ge = y * (1.f - __builtin_amdgcn_rcpf(1.f + __expf(z2)));
                    ((bf16_t*)(a.ws + WS_YG))[row * 512 + g * 16 + c] = f2bf(ge); }
            }
        }
    }
    if (!FULL) E[(size_t)ch * ST] = (f32x2){sr, si};
}
constexpr int S5_ROWB = 272, S5_LDS_WAVE = 32 * S5_ROWB;
template <bool FULL, int DIR>
__device__ __forceinline__ void s5m_dir(const Args& a, int l, int b, int g, int ch, int lane, LAS unsigned char* sl) {
    const bf16_t* PROJ = (const bf16_t*)(a.ws + WS_PROJ);
    const int ldg = (l * 2 + DIR) * NG + g, p1 = lane & 31, hi = lane >> 5;
    float lr[2], li[2], p4r[2], p4i[2];
#pragma unroll
    for (int s = 0; s < 2; ++s) { const f32x2 lm = ((const f32x2*)(a.ws + WS_LAMB))[ldg * ST + 32 * s + p1]; lr[s] = lm.x; li[s] = lm.y;
        const float q2r = lm.x * lm.x - lm.y * lm.y, q2i = 2.f * lm.x * lm.y; p4r[s] = q2r * q2r - q2i * q2i; p4i[s] = 2.f * q2r * q2i; }
    bf16x8 bfr[4];
#pragma unroll
    for (int j = 0; j < 4; ++j) { const f32x4* bb = (const f32x4*)((const f32x2*)(a.ws + WS_BBAR) + ((size_t)(ldg * ST + 32 * (j & 1) + p1)) * 16 + 8 * hi);
        const f32x4 t0 = bb[0], t1 = bb[1], t2 = bb[2], t3 = bb[3];
        u32x4 w;
        if ((j >> 1) == 0) { w.x = cvt_pk_bf16(t0.x, t0.z); w.y = cvt_pk_bf16(t1.x, t1.z); w.z = cvt_pk_bf16(t2.x, t2.z); w.w = cvt_pk_bf16(t3.x, t3.z); }
        else               { w.x = cvt_pk_bf16(t0.y, t0.w); w.y = cvt_pk_bf16(t1.y, t1.w); w.z = cvt_pk_bf16(t2.y, t2.w); w.w = cvt_pk_bf16(t3.y, t3.w); }
        bfr[j] = __builtin_bit_cast(bf16x8, w); }
    bf16x8 cfr[4];
    if (FULL) { const int c = lane & 15, kq = lane >> 4;
#pragma unroll
        for (int ks = 0; ks < 4; ++ks) { const int n0 = 32 * ks + 8 * kq;
            const float* cp = (ks < 2) ? (a.in[16] + ((size_t)ldg * 16 + c) * ST + n0) : (a.in[17] + ((size_t)ldg * 16 + c) * ST + (n0 - 64));
            const f32x4 t0 = ((const f32x4*)cp)[0], t1 = ((const f32x4*)cp)[1]; const float sg = (ks < 2) ? 1.f : -1.f;
            u32x4 w; w.x = cvt_pk_bf16(sg * t0.x, sg * t0.y); w.y = cvt_pk_bf16(sg * t0.z, sg * t0.w); w.z = cvt_pk_bf16(sg * t1.x, sg * t1.y); w.w = cvt_pk_bf16(sg * t1.z, sg * t1.w);
            cfr[ks] = __builtin_bit_cast(bf16x8, w); } }
    float cr[2] = {0.f, 0.f}, ci[2] = {0.f, 0.f};
    f32x2* E = (f32x2*)(a.ws + WS_E) + ((size_t)((b * NG + g) * 2 + DIR) * NCH) * ST;
    if (FULL) {
#pragma unroll
        for (int s = 0; s < 2; ++s) { float pr = lr[s], pi = li[s];
#pragma unroll
            for (int i = 0; i < 9; ++i) { const float t = pr * pr - pi * pi; pi = 2.f * pr * pi; pr = t; }
            if (DIR == 0) { for (int j = 0; j < ch; ++j) { const f32x2 e = E[(size_t)j * ST + 32 * s + p1]; const float t = pr * cr[s] - pi * ci[s] + e.x; ci[s] = pr * ci[s] + pi * cr[s] + e.y; cr[s] = t; } }
            else { for (int j = NCH - 1; j > ch; --j) { const f32x2 e = E[(size_t)j * ST + 32 * s + p1]; const float t = pr * cr[s] - pi * ci[s] + e.x; ci[s] = pr * ci[s] + pi * cr[s] + e.y; cr[s] = t; } } }
    }
    const size_t row0 = (size_t)b * SEQ + (size_t)ch * CHUNK;
    bf16x8 ua_next;
    { const size_t tk0 = row0 + (size_t)((DIR == 0) ? 0 : (CHUNK / 32 - 1)) * 32; const size_t tkA = (DIR == 0) ? tk0 + p1 : tk0 + 31 - p1;
      ua_next = *(const bf16x8*)(PROJ + tkA * PROJ_N + 512 + g * 16 + 8 * hi); }
    for (int tile = 0; tile < CHUNK / 32; ++tile) {
        const int tt = (DIR == 0) ? tile : (CHUNK / 32 - 1 - tile);
        const size_t tok0 = row0 + (size_t)tt * 32;
        const bf16x8 ua = ua_next;
        { const int tn = (tile + 1 < CHUNK / 32) ? tile + 1 : tile; const int ttn = (DIR == 0) ? tn : (CHUNK / 32 - 1 - tn);
          const size_t tk0 = row0 + (size_t)ttn * 32; const size_t tkA = (DIR == 0) ? tk0 + p1 : tk0 + 31 - p1;
          ua_next = *(const bf16x8*)(PROJ + tkA * PROJ_N + 512 + g * 16 + 8 * hi); }
        f32x16 acc[4];
#pragma unroll
        for (int j = 0; j < 4; ++j) { f32x16 z = {}; acc[j] = __builtin_amdgcn_mfma_f32_32x32x16_bf16(ua, bfr[j], z, 0, 0, 0); }
        float er[2][4], ei[2][4], eor[2][4], eoi[2][4];
#pragma unroll
        for (int s = 0; s < 2; ++s)
#pragma unroll
            for (int q = 0; q < 4; ++q) { float xr = acc[s][4 * q], xi = acc[2 + s][4 * q];
#pragma unroll
                for (int i = 1; i < 4; ++i) { const float t = lr[s] * xr - li[s] * xi + acc[s][4 * q + i]; xi = lr[s] * xi + li[s] * xr + acc[2 + s][4 * q + i]; xr = t; }
                { auto rr = __builtin_amdgcn_permlane32_swap(__float_as_uint(xr), __float_as_uint(xr), false, false); er[s][q] = __uint_as_float(rr[0]); eor[s][q] = __uint_as_float(rr[1]); }
                { auto ri = __builtin_amdgcn_permlane32_swap(__float_as_uint(xi), __float_as_uint(xi), false, false); ei[s][q] = __uint_as_float(ri[0]); eoi[s][q] = __uint_as_float(ri[1]); } }
        float cinr[2][4], cini[2][4];
#pragma unroll
        for (int s = 0; s < 2; ++s) { float c_r = cr[s], c_i = ci[s];
#pragma unroll
            for (int q = 0; q < 4; ++q) {
                const float c0r = c_r, c0i = c_i;
                { const float t = p4r[s] * c_r - p4i[s] * c_i + er[s][q]; c_i = p4r[s] * c_i + p4i[s] * c_r + ei[s][q]; c_r = t; }
                const float c1r = c_r, c1i = c_i;
                { const float t = p4r[s] * c_r - p4i[s] * c_i + eor[s][q]; c_i = p4r[s] * c_i + p4i[s] * c_r + eoi[s][q]; c_r = t; }
                cinr[s][q] = hi ? c1r : c0r; cini[s][q] = hi ? c1i : c0i; }
            cr[s] = c_r; ci[s] = c_i; }
        if (FULL) {
#pragma unroll
            for (int s = 0; s < 2; ++s)
#pragma unroll
                for (int q = 0; q < 4; ++q) { float xr = cinr[s][q], xi = cini[s][q];
#pragma unroll
                    for (int i = 0; i < 4; ++i) { const float t = lr[s] * xr - li[s] * xi + acc[s][4 * q + i]; xi = lr[s] * xi + li[s] * xr + acc[2 + s][4 * q + i]; xr = t;
                        acc[s][4 * q + i] = xr; acc[2 + s][4 * q + i] = xi; } }
#pragma unroll
            for (int j = 0; j < 4; ++j)
#pragma unroll
                for (int r = 0; r < 16; r += 2) { const unsigned w2 = cvt_pk_bf16(acc[j][r], acc[j][r + 1]);
                    const int rho = (r & 3) + 8 * (r >> 2) + 4 * hi; const int rw0 = (DIR == 0) ? rho : 31 - rho, rw1 = (DIR == 0) ? rho + 1 : 30 - rho;
                    *(LAS bf16_t*)(sl + rw0 * S5_ROWB + (32 * j + p1) * 2) = (bf16_t)(w2 & 0xffffu);
                    *(LAS bf16_t*)(sl + rw1 * S5_ROWB + (32 * j + p1) * 2) = (bf16_t)(w2 >> 16); }
#pragma unroll
            for (int mt = 0; mt < 2; ++mt) { f32x4 y = {0.f, 0.f, 0.f, 0.f};
#pragma unroll
                for (int ks = 0; ks < 4; ++ks) { const bf16x8 af = *(const LAS bf16x8*)(sl + (16 * mt + (lane & 15)) * S5_ROWB + (32 * ks + 8 * (lane >> 4)) * 2);
                    y = __builtin_amdgcn_mfma_f32_16x16x32_bf16(af, cfr[ks], y, 0, 0, 0); }
                const int c = lane & 15;
#pragma unroll
                for (int rg = 0; rg < 4; ++rg) { const size_t row = tok0 + 16 * mt + 4 * (lane >> 4) + rg;
                    float* yf = (float*)(a.ws + WS_YF) + row * 512 + g * 16 + c;
                    if (DIR == 0) { *yf = y[rg]; }
                    else { const float u = bf2f(PROJ[row * PROJ_N + 512 + g * 16 + c]);
                        const float yy = y[rg] + *yf + a.in[18][l * 512 + g * 16 + c] * u;
                        const float z2 = 1.5957691216057308f * (yy + 0.044715f * yy * yy * yy);
                        const float ge = yy * (1.f - __builtin_amdgcn_rcpf(1.f + __expf(z2)));
                        ((bf16_t*)(a.ws + WS_YG))[row * 512 + g * 16 + c] = f2bf(ge); } } }
        }
    }
    if (!FULL) { if (hi == 0) {
#pragma unroll
        for (int s = 0; s < 2; ++s) E[(size_t)ch * ST + 32 * s + p1] = (f32x2){cr[s], ci[s]}; } }
}
#ifndef S5_VALU
#define S5_VALU 0
#endif
template <bool FULL>
__device__ __forceinline__ void s5_item(const Args& a, int l, int item, int lane, LAS unsigned char* sl) {
    const int ch = item & (NCH - 1), g = (item >> 5) & 31, b = item >> 10;
#if S5_VALU
    s5_dir<FULL, 0>(a, l, b, g, ch, lane);
    s5_dir<FULL, 1>(a, l, b, g, ch, lane);
#else
    s5m_dir<FULL, 0>(a, l, b, g, ch, lane, sl);
    s5m_dir<FULL, 1>(a, l, b, g, ch, lane, sl);
#endif
}


#define XB_TMO      128
#define XB_XCNT(j)  (256  + 64 * (j))
#define XB_XSUB(j)  (1280 + 64 * (j))
#define XB_XGEN(j)  (2304 + 64 * (j))
#define XB_TOP      3328
#define XB_TOPGEN   3392
#define XCD_BAR_WORDS 3456
#define XB_SPIN_CAP (1u << 18)
__device__ __forceinline__ unsigned xb_ld(unsigned* p)              { return __hip_atomic_load(p, __ATOMIC_RELAXED, __HIP_MEMORY_SCOPE_AGENT); }
__device__ __forceinline__ unsigned xb_add(unsigned* p, unsigned v) { return __hip_atomic_fetch_add(p, v, __ATOMIC_RELAXED, __HIP_MEMORY_SCOPE_AGENT); }
__device__ __forceinline__ unsigned xb_xcc_id() { return (unsigned)__builtin_amdgcn_s_getreg((3 << 11) | 20) & 0xFu; }
#define XB_SPIN(cond, bar) do { unsigned _sp = 0; while (cond) { __builtin_amdgcn_s_sleep(1); \
    if ((++_sp & 255u) == 0u) { if (xb_ld(&(bar)[XB_TMO])) break; if (_sp > XB_SPIN_CAP) { atomicAdd(&(bar)[XB_TMO], 1u); break; } } } } while (0)
struct XcdBarrier { unsigned* bar; unsigned x; volatile LAS unsigned* st; };
__device__ __forceinline__ XcdBarrier xcd_barrier_post(unsigned* bar, volatile LAS unsigned* st) {
    XcdBarrier b; b.bar = bar; b.x = xb_xcc_id(); b.st = st;
    if (threadIdx.x == 0) (void)xb_add(&bar[XB_XCNT(b.x)], 1u);
    return b;
}
__device__ __forceinline__ void xcd_barrier_complete(unsigned* bar, unsigned x, unsigned& nloc, unsigned& nx) {
    const unsigned G = gridDim.x * gridDim.y * gridDim.z;
    unsigned sum, cnt, mine, sp = 0u;
    for (;;) {
        sum = 0u; cnt = 0u; mine = 0u;
#pragma unroll
        for (unsigned j = 0; j < 16; ++j) { const unsigned c = xb_ld(&bar[XB_XCNT(j)]); sum += c; cnt += (c > 0u) ? 1u : 0u; mine = (j == x) ? c : mine; }
        if (sum == G) break;
        __builtin_amdgcn_s_sleep(1);
        if ((++sp & 255u) == 0u) { if (xb_ld(&bar[XB_TMO])) break; if (sp > XB_SPIN_CAP) { atomicAdd(&bar[XB_TMO], 1u); break; } }
    }
    nloc = mine > 0u ? mine : 1u; nx = cnt > 0u ? cnt : 1u;
}
__device__ __forceinline__ void xcd_barrier(const XcdBarrier& b) {
    asm volatile("s_waitcnt vmcnt(0)" ::: "memory");
    __syncthreads();
    if (threadIdx.x == 0) {
        unsigned* bar = b.bar;
        __builtin_amdgcn_s_waitcnt(0);
        unsigned nloc = b.st[0], nx = b.st[1];
        if (nloc == 0u) { xcd_barrier_complete(bar, b.x, nloc, nx); b.st[0] = nloc; b.st[1] = nx; }
        const unsigned old = xb_add(&bar[XB_XSUB(b.x)], 1u);
        const unsigned gen = old / nloc;
        if (old + 1u == (gen + 1u) * nloc) {
            __builtin_amdgcn_fence(__ATOMIC_RELEASE, "agent");
            asm volatile("s_waitcnt vmcnt(0)" ::: "memory");
            const unsigned og = xb_add(&bar[XB_TOP], 1u);
            const unsigned tg = og / nx;
            if (og + 1u == (tg + 1u) * nx) xb_add(&bar[XB_TOPGEN], 1u);
            else XB_SPIN(xb_ld(&bar[XB_TOPGEN]) == tg, bar);
            __builtin_amdgcn_fence(__ATOMIC_ACQUIRE, "agent");
            xb_add(&bar[XB_XGEN(b.x)], 1u);
            asm volatile("s_waitcnt vmcnt(0)" ::: "memory");
        } else {
            XB_SPIN(xb_ld(&bar[XB_XGEN(b.x)]) == gen, bar);
            __builtin_amdgcn_fence(__ATOMIC_ACQUIRE, "agent");
            asm volatile("s_waitcnt vmcnt(0)" ::: "memory");
        }
    }
    __syncthreads();
}

constexpr int NPH_LAYER = 11, NPH = 1 + DEPTH * NPH_LAYER;
#ifndef PROBE_GEMM
#define PROBE_GEMM 0
#endif
template <class E_> __device__ __forceinline__ constexpr int gemm_rep_(const E_&) { return 1 + PROBE_GEMM; }
__device__ __forceinline__ constexpr int gemm_rep_(const pg8::EpiGateAcc&) { return 1; }
#define GEMM_REP(E) gemm_rep_(E)
#ifndef PROBE_ATT
#define PROBE_ATT 0
#endif
#ifndef PROBE_S5
#define PROBE_S5 0
#endif

template <int SP>
__device__ __forceinline__ void layer_phase(const Args& a, const int l, LAS unsigned char* ldsl, unsigned char* lds, const int G, const int bx, const int vcu, const int gw, const int NGW, const int lane_in) {
    int tid_ = threadIdx.x; asm volatile("" : "+v"(tid_));
    const int lane = tid_ & 63; (void)lane_in;
    unsigned char* ws = a.ws;
    const bf16_t* WL = (const bf16_t*)(ws + WS_W + (size_t)l * W_LAYER);
    const float* xin = (l == 0) ? a.in[0] : a.out;
    bf16_t* PROJ = (bf16_t*)(ws + WS_PROJ);
    if constexpr (SP == 0) {
        bf16_t* XN = (bf16_t*)(ws + WS_XN);
        for (int m = gw; m < M; m += 2 * NGW) { const int m2 = (m + NGW < M) ? m + NGW : m; norm_row2(xin + (size_t)m * DM, XN + (size_t)m * DM, xin + (size_t)m2 * DM, XN + (size_t)m2 * DM, lane); }
    } else if constexpr (SP == 1) {
        pg8::Gemm g{(const bf16_t*)(ws + WS_XN), (const bf16_t*)((const char*)WL + W0), M, PROJ_N, DM, DM};
        pg8::StaticOrder S; S.init(M, PROJ_N, G, bx);
        pg8::EpiBf E{PROJ, PROJ_N, 4};
        for (int rep_ = 0; rep_ < GEMM_REP(E); ++rep_) pg8::gemm_phase(ldsl, g, S, E);
    } else if constexpr (SP == 2) {
        { pg8::Gemm g{PROJ, (const bf16_t*)((const char*)WL + W1), M, 768, 256, PROJ_N};
          pg8::StaticOrder S; S.init(M, 768, G, bx);
          pg8::EpiBf E{(bf16_t*)(ws + WS_Q), LDQ, 1 << 30};
          for (int rep_ = 0; rep_ < GEMM_REP(E); ++rep_) pg8::gemm_phase(ldsl, g, S, E); }
        { pg8::Gemm g{PROJ + 256, (const bf16_t*)((const char*)WL + W2), M, 1280, 128, PROJ_N};
          pg8::StaticOrder S; S.init(M, 1280, G, (G % 16 == 0) ? (bx + G / 2) % G : bx);
          pg8::EpiBf E{(bf16_t*)(ws + WS_KV), LDKV, 1 << 30};
          for (int rep_ = 0; rep_ < GEMM_REP(E); ++rep_) pg8::gemm_phase(ldsl, g, S, E); }
        { int t2 = threadIdx.x; asm volatile("" : "+v"(t2)); const int lane2 = t2 & 63, wave2 = __builtin_amdgcn_readfirstlane(t2 >> 6);
        for (int rep = 0; rep < 1 + PROBE_S5; ++rep)
        for (int it = gw; it < BATCH * NG * NCH; it += NGW) s5_item<false>(a, l, it, lane2, ldsl + wave2 * S5_LDS_WAVE); }
    } else if constexpr (SP == 3) {
        for (int m = gw; m < M; m += NGW) postproc_row(a, l, m, lane);
    } else if constexpr (SP == 4) {
        bf16_t* Q = (bf16_t*)(ws + WS_Q); const bf16_t* KV = (const bf16_t*)(ws + WS_KV);
#if PROBE_ATT
        { bf16_t* DUM = (bf16_t*)(ws + WS_YF);
          for (int u = vcu; u < BATCH * NH * (SEQ / 256); u += G) {
            const int bh = u / (SEQ / 256), qb = u % (SEQ / 256), b = bh / NH, h = bh % NH;
            __syncthreads();
            bf16_t* Qb = Q + ((size_t)b * SEQ + (size_t)qb * 256) * LDQ + h * QKD;
            bf16_t* Ob = DUM + ((size_t)b * SEQ + (size_t)qb * 256) * LDQ + h * QKD;
            const bf16_t* Kh = KV + (size_t)b * SEQ * LDKV + h * QKD;
            const bf16_t* Vh = KV + (size_t)b * SEQ * LDKV + 768 + h * VD;
            att::attn_body(Qb, Kh, Vh, Ob, SEQ, (char*)lds);
          }
          cg::this_grid().sync(); }
#endif
        for (int u = vcu; u < BATCH * NH * (SEQ / 256); u += G) {
            const int bh = u / (SEQ / 256), qb = u % (SEQ / 256), b = bh / NH, h = bh % NH;
            __syncthreads();
            bf16_t* Qb = Q + ((size_t)b * SEQ + (size_t)qb * 256) * LDQ + h * QKD;
            const bf16_t* Kh = KV + (size_t)b * SEQ * LDKV + h * QKD;
            const bf16_t* Vh = KV + (size_t)b * SEQ * LDKV + 768 + h * VD;
            bf16_t* Ob = (bf16_t*)(ws + WS_ATT) + ((size_t)b * SEQ + (size_t)qb * 256) * 512 + h * VD;
            att::attn_pp(Qb, Kh, Vh, Ob, 512, SEQ, (char*)lds);
        }
        __syncthreads();
        { int t2 = threadIdx.x; asm volatile("" : "+v"(t2)); const int lane2 = t2 & 63, wave2 = __builtin_amdgcn_readfirstlane(t2 >> 6);
        for (int rep = 0; rep < 1 + PROBE_S5; ++rep)
        for (int it = gw; it < BATCH * NG * NCH; it += NGW) s5_item<true>(a, l, it, lane2, ldsl + wave2 * S5_LDS_WAVE); }
    } else if constexpr (SP == 5) {
        pg8::Gemm g{(const bf16_t*)(ws + WS_YG), (const bf16_t*)((const char*)WL + W4), M, 2048, 512, 512};
        pg8::StaticOrder S; S.init(M, 2048, G, bx);
        pg8::EpiPair<0> E{(bf16_t*)(ws + WS_MIX), DM, PROJ, PROJ_N, 2048};
        for (int rep_ = 0; rep_ < GEMM_REP(E); ++rep_) pg8::gemm_phase(ldsl, g, S, E);
    } else if constexpr (SP == 6) {
        pg8::Gemm g{(const bf16_t*)(ws + WS_ATT), (const bf16_t*)((const char*)WL + W3), M, 1024, 512, 512};
        pg8::StaticOrder S; S.init(M, 1024, G, bx);
        pg8::EpiGateAcc E{(bf16_t*)(ws + WS_MIX), DM, PROJ, PROJ_N, 1024};
        for (int rep_ = 0; rep_ < GEMM_REP(E); ++rep_) pg8::gemm_phase(ldsl, g, S, E);
    } else if constexpr (SP == 7) {
        pg8::Gemm g{(const bf16_t*)(ws + WS_MIX), (const bf16_t*)((const char*)WL + W5), M, 1024, 1024, DM};
        pg8::StaticOrder S; S.init(M, 1024, G, bx);
        pg8::EpiRes E{xin, (float*)(ws + WS_H)};
        for (int rep_ = 0; rep_ < GEMM_REP(E); ++rep_) pg8::gemm_phase(ldsl, g, S, E);
    } else if constexpr (SP == 8) {
        const float* H = (const float*)(ws + WS_H); bf16_t* HN = (bf16_t*)(ws + WS_HN);
        for (int m = gw; m < M; m += 2 * NGW) { const int m2 = (m + NGW < M) ? m + NGW : m; norm_row2(H + (size_t)m * DM, HN + (size_t)m * DM, H + (size_t)m2 * DM, HN + (size_t)m2 * DM, lane); }
    } else if constexpr (SP == 9) {
        pg8::Gemm g{(const bf16_t*)(ws + WS_HN), (const bf16_t*)((const char*)WL + W6), M, 2 * DFF, 1024, DM};
        pg8::StaticOrder S; S.init(M, 2 * DFF, G, bx);
        pg8::EpiPair<1> E{PROJ, DFF, nullptr, 0, 0};
        for (int rep_ = 0; rep_ < GEMM_REP(E); ++rep_) pg8::gemm_phase(ldsl, g, S, E);
    } else {
        pg8::Gemm g{PROJ, (const bf16_t*)((const char*)WL + W7), M, 1024, DFF, DFF};
        pg8::StaticOrder S; S.init(M, 1024, G, bx);
        pg8::EpiRes E{(const float*)(ws + WS_H), a.out};
        for (int rep_ = 0; rep_ < GEMM_REP(E); ++rep_) pg8::gemm_phase(ldsl, g, S, E);
    }
}


__global__ void __launch_bounds__(512, 2) mega_fwd(Args a) {
    __builtin_assume(__builtin_amdgcn_workitem_id_y() == 0); __builtin_assume(__builtin_amdgcn_workitem_id_z() == 0);
    extern __shared__ __attribute__((aligned(16))) unsigned char lds[];
    cg::grid_group grid = cg::this_grid();
    const int tid = threadIdx.x, lane = tid & 63, wave = __builtin_amdgcn_readfirstlane(tid >> 6);
    const int G = gridDim.x, bx = blockIdx.x;
    const int vcu = (G % 8 == 0) ? (bx % 8) * (G / 8) + bx / 8 : bx;
    const int gw = vcu * 8 + wave, NGW = G * 8;
    LAS unsigned char* ldsl = (LAS unsigned char*)lds;
    unsigned char* ws = a.ws;


    const int lo = a.ph_lo, hi = a.ph_hi;
    unsigned* barw = (unsigned*)a.ws;
    volatile LAS unsigned* bst = (volatile LAS unsigned*)(ldsl + 131072);
    if (tid < 2) bst[tid] = 0u;
    if (bx == 0) { for (int i = tid; i < XCD_BAR_WORDS; i += 512) __hip_atomic_store(barw + i, 0u, __ATOMIC_RELAXED, __HIP_MEMORY_SCOPE_AGENT); }
    __syncthreads();
#define IN(k) (lo <= (k) && (k) < hi)
    if (IN(0)) p0_prologue(a, ldsl, gw, NGW, wave, lane);
    grid.sync();
    const XcdBarrier xbar = xcd_barrier_post(barw, bst);
#define SEAM(k) do { if ((k) + 1 < hi) xcd_barrier(xbar); } while (0)
#define LAYER(l) \
    if (IN(1 + (l) * NPH_LAYER + 0))  { layer_phase<0>(a, (l), ldsl, lds, G, bx, vcu, gw, NGW, lane);  SEAM(1 + (l) * NPH_LAYER + 0); } \
    if (IN(1 + (l) * NPH_LAYER + 1))  { layer_phase<1>(a, (l), ldsl, lds, G, bx, vcu, gw, NGW, lane);  SEAM(1 + (l) * NPH_LAYER + 1); } \
    if (IN(1 + (l) * NPH_LAYER + 2))  { layer_phase<2>(a, (l), ldsl, lds, G, bx, vcu, gw, NGW, lane);  SEAM(1 + (l) * NPH_LAYER + 2); } \
    if (IN(1 + (l) * NPH_LAYER + 3))  { layer_phase<3>(a, (l), ldsl, lds, G, bx, vcu, gw, NGW, lane);  SEAM(1 + (l) * NPH_LAYER + 3); } \
    if (IN(1 + (l) * NPH_LAYER + 4))  { layer_phase<4>(a, (l), ldsl, lds, G, bx, vcu, gw, NGW, lane);  SEAM(1 + (l) * NPH_LAYER + 4); } \
    if (IN(1 + (l) * NPH_LAYER + 5))  { layer_phase<5>(a, (l), ldsl, lds, G, bx, vcu, gw, NGW, lane);  SEAM(1 + (l) * NPH_LAYER + 5); } \
    if (IN(1 + (l) * NPH_LAYER + 6))  { layer_phase<6>(a, (l), ldsl, lds, G, bx, vcu, gw, NGW, lane);  SEAM(1 + (l) * NPH_LAYER + 6); } \
    if (IN(1 + (l) * NPH_LAYER + 7))  { layer_phase<7>(a, (l), ldsl, lds, G, bx, vcu, gw, NGW, lane);  SEAM(1 + (l) * NPH_LAYER + 7); } \
    if (IN(1 + (l) * NPH_LAYER + 8))  { layer_phase<8>(a, (l), ldsl, lds, G, bx, vcu, gw, NGW, lane);  SEAM(1 + (l) * NPH_LAYER + 8); } \
    if (IN(1 + (l) * NPH_LAYER + 9))  { layer_phase<9>(a, (l), ldsl, lds, G, bx, vcu, gw, NGW, lane);  SEAM(1 + (l) * NPH_LAYER + 9); } \
    if (IN(1 + (l) * NPH_LAYER + 10)) { layer_phase<10>(a, (l), ldsl, lds, G, bx, vcu, gw, NGW, lane); SEAM(1 + (l) * NPH_LAYER + 10); }
    LAYER(0)
    LAYER(1)
#undef LAYER
#undef IN
#undef SEAM
}

extern "C" void kernel_launch(void* const* d_in, const int* in_sizes, int n_in, void* d_out, int out_size, void* d_ws, size_t ws_size, hipStream_t stream) {
    static int grid = 0;
    if (grid == 0) {
        if (n_in != 25 || in_sizes[0] != M * DM || out_size != M * DM || ws_size < WS_END) {
            fprintf(stderr, "kernel_launch: shape/workspace mismatch (n_in %d, in0 %d, out %d, ws %zu, need %zu); nothing launched\n", n_in, n_in > 0 ? in_sizes[0] : -1, out_size, ws_size, (size_t)WS_END);
            grid = -1; return; }
        int dev = 0, cus = 0, per_cu = 0;
        if (hipGetDevice(&dev) != hipSuccess || hipDeviceGetAttribute(&cus, hipDeviceAttributeMultiprocessorCount, dev) != hipSuccess) { grid = -1; return; }
        if (hipFuncSetAttribute((const void*)mega_fwd, hipFuncAttributeMaxDynamicSharedMemorySize, LDS_BYTES) != hipSuccess) { fprintf(stderr, "kernel_launch: hipFuncSetAttribute failed\n"); grid = -1; return; }
        if (hipOccupancyMaxActiveBlocksPerMultiprocessor(&per_cu, (const void*)mega_fwd, 512, LDS_BYTES) != hipSuccess || per_cu < 1) {
            fprintf(stderr, "kernel_launch: occupancy query reports %d blocks per CU\n", per_cu); per_cu = 1; }
        (void)hipGetLastError();
        grid = cus;
    }
    if (grid < 0) return;
    Args a{};
    for (int i = 0; i < 25; ++i) a.in[i] = (const float*)d_in[i];
    a.out = (float*)d_out; a.ws = (unsigned char*)d_ws; a.ph_lo = 0; a.ph_hi = NPH;
    void* args[] = {&a};
    hipError_t e = hipLaunchCooperativeKernel((const void*)mega_fwd, dim3(grid), dim3(512), args, LDS_BYTES, stream);
    if (e != hipSuccess) fprintf(stderr, "kernel_launch: cooperative launch failed: %s (grid %d)\n", hipGetErrorString(e), grid);
}
```

```cpp
#include <hip/hip_runtime.h>
#include <hip/hip_cooperative_groups.h>
#include <cstdio>
#include <cstdint>
namespace cg = cooperative_groups;

#define LAS __attribute__((address_space(3)))
typedef unsigned short bf16_t;
typedef short bf16x8 __attribute__((ext_vector_type(8)));
typedef short s16x4 __attribute__((ext_vector_type(4)));
typedef float f32x4 __attribute__((ext_vector_type(4)));
typedef float f32x2 __attribute__((ext_vector_type(2)));
typedef float f32x16 __attribute__((ext_vector_type(16)));
typedef unsigned u32x4 __attribute__((ext_vector_type(4)));
typedef unsigned u32x2 __attribute__((ext_vector_type(2)));

constexpr int DM = 1024, BATCH = 2, SEQ = 16384, M = BATCH * SEQ, DEPTH = 2;
constexpr int NH = 8, QKD = 96, VD = 64;
constexpr int NG = 32, ST = 64;
constexpr int DFF = 2816;
constexpr int INC = 2976;
constexpr int PROJ_N = 3072;
constexpr int LDQ = 768, LDKV = 1280;
constexpr float EPS = 1e-6f;
constexpr int CHUNK = 512, NCH = SEQ / CHUNK;

constexpr size_t MiB = 1u << 20;
constexpr size_t WS_LAMB = 64 * 1024;
constexpr size_t WS_BBAR = 1 * MiB;
constexpr size_t WS_E = 2 * MiB;
constexpr size_t WS_W = 4 * MiB;
constexpr size_t W_LAYER = 30 * MiB;
constexpr size_t W0 = 0, W1 = 6291456, W2 = 6684672, W3 = 7012352, W4 = 8585216, W5 = 10682368, W6 = 12779520, W7 = 24313856;
constexpr size_t WS_PROJ = 64 * MiB;
constexpr size_t WS_Q = 256 * MiB;
constexpr size_t WS_KV = 304 * MiB;
constexpr size_t WS_XN = 256 * MiB;
constexpr size_t WS_H = 256 * MiB;
constexpr size_t WS_YF = 384 * MiB;
constexpr size_t WS_MIX = 384 * MiB;
constexpr size_t WS_HN = 384 * MiB;
constexpr size_t WS_YG = 448 * MiB;
constexpr size_t WS_ATT = 480 * MiB;
constexpr size_t WS_END = 512 * MiB;
constexpr int LDS_BYTES = 131072 + 256;

struct Args { const float* in[25]; float* out; unsigned char* ws; int ph_lo, ph_hi; };

__device__ __forceinline__ unsigned cvt_pk_bf16(float lo, float hi) { unsigned r; asm("v_cvt_pk_bf16_f32 %0, %1, %2" : "=v"(r) : "v"(lo), "v"(hi)); return r; }
__device__ __forceinline__ float bf_lo(unsigned w) { return __uint_as_float(w << 16); }
__device__ __forceinline__ float bf_hi(unsigned w) { return __uint_as_float(w & 0xffff0000u); }
__device__ __forceinline__ float bf2f(bf16_t h) { return __uint_as_float(((unsigned)h) << 16); }
__device__ __forceinline__ bf16_t f2bf(float f) { return (bf16_t)(cvt_pk_bf16(f, 0.f) & 0xffffu); }
__device__ __forceinline__ float sigm(float x) { return __builtin_amdgcn_rcpf(1.f + __expf(-x)); }
__device__ __forceinline__ float wave_sum(float v) {
#pragma unroll
    for (int o = 1; o < 64; o <<= 1) v += __shfl_xor(v, o);
    return v;
}

namespace pg8 {
constexpr int BM = 256, BK = 64, HALF = 128, HTB = HALF * BK * 2, NXCD = 8, WGM = 8;
__host__ __device__ __forceinline__ int lds_byte(int r, int c) { const int st = (r >> 4) * 2 + (c >> 5), rr = r & 15, cc = c & 31, ob = rr * 64 + cc * 2; return st * 1024 + (ob ^ (((ob >> 9) & 1) << 5)); }
__host__ __device__ __forceinline__ void stage_rc(int b, int& R, int& C) { const int st = b / 1024, sb = b % 1024, swz = sb ^ (((sb >> 9) & 1) << 5); R = (st >> 1) * 16 + swz / 64; C = (st & 1) * 32 + (swz % 64) / 2; }
__host__ __device__ __forceinline__ int perm32(int rho) { const int n = rho >> 4, i = rho & 15; return 8 * (i >> 2) + 4 * n + (i & 3); }

struct Unit { int pm, pn; };
struct Gemm { const bf16_t* A; const bf16_t* Bt; int M, N, K, lda; };

struct StaticOrder {
    int nM, nN, nwg, G, c;
    __device__ void init(int M_, int N_, int G_, int c_) { nM = M_ / BM; nN = N_ / BM; nwg = nM * nN; G = G_; c = c_; }
    __device__ bool next(int i, Unit& u) const {
        const long L = (long)i * G + c; if (L >= nwg) return false;
        int wgid = (int)L; { const int q = nwg / NXCD, r = nwg % NXCD, xcd = wgid % NXCD, off = wgid / NXCD; wgid = (xcd < r ? xcd * (q + 1) : r * (q + 1) + (xcd - r) * q) + off; }
        const int nig = WGM * nN, gid = wgid / nig, fm = gid * WGM, gsz = (nM - fm) < WGM ? (nM - fm) : WGM;
        u.pm = fm + ((wgid % nig) % gsz); u.pn = (wgid % nig) / gsz; return true;
    }
};

typedef f32x4 Acc[2][2][4][2];

struct EpiBf {
    static constexpr bool PERM = true;
    bf16_t* O; int ldc; int sig_from;
    __device__ __forceinline__ void operator()(const Acc& acc, const Unit& u, int wr, int wc, int fr, int fq) const {
        const int row0 = u.pm * BM + wr * 64 + fr, col0 = u.pn * BM + wc * 32 + 8 * fq; const bool sg = u.pn >= sig_from;
#pragma unroll
        for (int ai = 0; ai < 2; ++ai)
#pragma unroll
            for (int m = 0; m < 4; ++m) { bf16_t* rowp = O + (size_t)(row0 + ai * HALF + m * 16) * ldc + col0;
#pragma unroll
                for (int bj = 0; bj < 2; ++bj) { f32x4 v0 = acc[ai][bj][m][0], v1 = acc[ai][bj][m][1];
                    if (sg) {
#pragma unroll
                        for (int i = 0; i < 4; ++i) { v0[i] = sigm(v0[i]); v1[i] = sigm(v1[i]); } }
                    u32x4 w; w.x = cvt_pk_bf16(v0[0], v0[1]); w.y = cvt_pk_bf16(v0[2], v0[3]); w.z = cvt_pk_bf16(v1[0], v1[1]); w.w = cvt_pk_bf16(v1[2], v1[3]);
                    *(u32x4*)(rowp + bj * HALF) = w; }
                asm volatile("" ::: "memory"); }
    }
};
template <int MODE> struct EpiPair {
    static constexpr bool PERM = true;
    bf16_t* O; int ldc; const bf16_t* gate; int ldg, goff;
    __device__ __forceinline__ void operator()(const Acc& acc, const Unit& u, int wr, int wc, int fr, int fq) const {
        const int row0 = u.pm * BM + wr * 64 + fr, j00 = u.pn * 128 + wc * 16 + 4 * fq;
#pragma unroll
        for (int ai = 0; ai < 2; ++ai)
#pragma unroll
            for (int m = 0; m < 4; ++m) { const size_t row = (size_t)(row0 + ai * HALF + m * 16);
#pragma unroll
                for (int bj = 0; bj < 2; ++bj) { const int j0 = j00 + bj * 64; const f32x4 a = acc[ai][bj][m][0], b = acc[ai][bj][m][1]; float o[4];
                    if (MODE == 0) { const u32x2 gw = *(const u32x2*)(gate + row * ldg + goff + j0);
                        const float g0 = bf_lo(gw.x), g1 = bf_hi(gw.x), g2 = bf_lo(gw.y), g3 = bf_hi(gw.y);
                        o[0] = g0 * a[0] * sigm(b[0]); o[1] = g1 * a[1] * sigm(b[1]); o[2] = g2 * a[2] * sigm(b[2]); o[3] = g3 * a[3] * sigm(b[3]);
                    } else {
#pragma unroll
                        for (int i = 0; i < 4; ++i) o[i] = a[i] * sigm(a[i]) * b[i]; }
                    u32x2 w; w.x = cvt_pk_bf16(o[0], o[1]); w.y = cvt_pk_bf16(o[2], o[3]);
                    *(u32x2*)(O + row * ldc + j0) = w; }
                asm volatile("" ::: "memory"); }
    }
};
struct EpiGateAcc {
    static constexpr bool PERM = true;
    bf16_t* O; int ldc; const bf16_t* gate; int ldg, goff;
    __device__ __forceinline__ void operator()(const Acc& acc, const Unit& u, int wr, int wc, int fr, int fq) const {
        const int row0 = u.pm * BM + wr * 64 + fr, col0 = u.pn * BM + wc * 32 + 8 * fq;
#pragma unroll
        for (int ai = 0; ai < 2; ++ai)
#pragma unroll
            for (int m = 0; m < 4; ++m) { const size_t row = (size_t)(row0 + ai * HALF + m * 16);
#pragma unroll
                for (int bj = 0; bj < 2; ++bj) { const int col = col0 + bj * HALF; const f32x4 v0 = acc[ai][bj][m][0], v1 = acc[ai][bj][m][1];
                    const u32x4 gw = *(const u32x4*)(gate + row * ldg + goff + col); const u32x4 mw = *(const u32x4*)(O + row * ldc + col);
                    u32x4 w;
                    w.x = cvt_pk_bf16(bf_lo(gw.x) * v0[0] + bf_lo(mw.x), bf_hi(gw.x) * v0[1] + bf_hi(mw.x));
                    w.y = cvt_pk_bf16(bf_lo(gw.y) * v0[2] + bf_lo(mw.y), bf_hi(gw.y) * v0[3] + bf_hi(mw.y));
                    w.z = cvt_pk_bf16(bf_lo(gw.z) * v1[0] + bf_lo(mw.z), bf_hi(gw.z) * v1[1] + bf_hi(mw.z));
                    w.w = cvt_pk_bf16(bf_lo(gw.w) * v1[2] + bf_lo(mw.w), bf_hi(gw.w) * v1[3] + bf_hi(mw.w));
                    *(u32x4*)(O + row * ldc + col) = w; }
                asm volatile("" ::: "memory"); }
    }
};
struct EpiRes {
    static constexpr bool PERM = false;
    const float* base; float* out;
    __device__ __forceinline__ void operator()(const Acc& acc, const Unit& u, int wr, int wc, int fr, int fq) const {
        const int row0 = u.pm * BM + wr * 64 + fr, col0 = u.pn * BM + wc * 32 + 4 * fq;
#pragma unroll
        for (int ai = 0; ai < 2; ++ai)
#pragma unroll
            for (int m = 0; m < 4; ++m) { const size_t off = (size_t)(row0 + ai * HALF + m * 16) * DM + col0;
#pragma unroll
                for (int bj = 0; bj < 2; ++bj)
#pragma unroll
                    for (int n = 0; n < 2; ++n) { const f32x4 bs = *(const f32x4*)(base + off + bj * HALF + n * 16);
                        *(f32x4*)(out + off + bj * HALF + n * 16) = bs + acc[ai][bj][m][n]; }
                asm volatile("" ::: "memory"); }
    }
};

template <class Epi>
__device__ __forceinline__ void gemm_phase(LAS unsigned char* lds, const Gemm g, const StaticOrder& S, const Epi& E) {
    int tid = threadIdx.x; asm volatile("" : "+v"(tid));
    const int wid = __builtin_amdgcn_readfirstlane(tid >> 6), lane = tid & 63, wr = wid >> 2, wc = wid & 3, fr = lane & 15, fq = lane >> 4;
    const int K = g.K, nt = K / BK, lda = g.lda;
    unsigned voffA[2], voffB[2];
#pragma unroll
    for (int i = 0; i < 2; ++i) { int R, C; stage_rc(tid * 16 + i * 8192, R, C); const int Rb = Epi::PERM ? ((R & ~31) + perm32(R & 31)) : R;
        voffA[i] = (unsigned)(R * lda + C) * 2u; voffB[i] = (unsigned)(Rb * K + C) * 2u; }
    const size_t kstep = (size_t)(BK * 2);
    const size_t hA = (size_t)HALF * lda * 2, hB = (size_t)HALF * K * 2;
    const size_t tA = 2 * hA, tB = 2 * hB;
    const unsigned ldsw = (unsigned)wid * 1024u;
    const int aoff = lds_byte(wr * 64 + fr, fq * 8), boff = lds_byte(wc * 32 + fr, fq * 8);
#define PG8_SA(b, h) (((b) * 2 + (h)) * HTB)
#define PG8_SB(b, h) ((4 + (b) * 2 + (h)) * HTB)
#define PG8_STAGE(bufoff, gbase, voff) do { _Pragma("unroll") for (int _i = 0; _i < 2; ++_i) \
        __builtin_amdgcn_global_load_lds((const unsigned*)((const char*)(gbase) + (voff)[_i]), (LAS unsigned*)(lds + (bufoff) + ldsw + _i * 8192), 16, 0, 0); } while (0)
#define PG8_LDA(dst, b, h) do { _Pragma("unroll") for (int m = 0; m < 4; ++m) _Pragma("unroll") for (int k = 0; k < 2; ++k) dst[m][k] = *(const LAS bf16x8*)(lds + PG8_SA(b, h) + aoff + m * 2048 + k * 1024); } while (0)
#define PG8_LDB(dst, b, h) do { _Pragma("unroll") for (int n = 0; n < 2; ++n) _Pragma("unroll") for (int k = 0; k < 2; ++k) dst[n][k] = *(const LAS bf16x8*)(lds + PG8_SB(b, h) + boff + n * 2048 + k * 1024); } while (0)
#define PG8_MMA(ai, bj, At, Bt) do { __builtin_amdgcn_s_setprio(1); _Pragma("unroll") for (int m = 0; m < 4; ++m) _Pragma("unroll") for (int n = 0; n < 2; ++n) _Pragma("unroll") for (int k = 0; k < 2; ++k) \
        acc[ai][bj][m][n] = __builtin_amdgcn_mfma_f32_16x16x32_bf16(Bt[n][k], At[m][k], acc[ai][bj][m][n], 0, 0, 0); __builtin_amdgcn_s_setprio(0); } while (0)
#define PG8_WAIT_V(n) asm volatile("s_waitcnt vmcnt(" #n ")" ::: "memory")
#define PG8_WAIT_L(n) asm volatile("s_waitcnt lgkmcnt(" #n ")" ::: "memory")
#define PG8_BAR __builtin_amdgcn_s_barrier()
#define PG8_SCHED __builtin_amdgcn_sched_barrier(0)
    Unit cur, nxt; int ui = 0;
    if (!S.next(0, cur)) return;
    Acc acc;
#pragma unroll
    for (int a = 0; a < 2; ++a)
#pragma unroll
        for (int b = 0; b < 2; ++b)
#pragma unroll
            for (int m = 0; m < 4; ++m)
#pragma unroll
                for (int n = 0; n < 2; ++n) acc[a][b][m][n] = (f32x4){0.f, 0.f, 0.f, 0.f};
    bf16x8 At[4][2], B0[2][2], B1[2][2];
    const char* cA = (const char*)g.A + (size_t)cur.pm * tA; const char* cB = (const char*)g.Bt + (size_t)cur.pn * tB;
    PG8_STAGE(PG8_SB(0, 0), cB, voffB); PG8_STAGE(PG8_SB(0, 1), cB + hB, voffB); PG8_STAGE(PG8_SA(0, 0), cA, voffA); PG8_STAGE(PG8_SA(0, 1), cA + hA, voffA);
    if (wr == 1) PG8_BAR;
    PG8_WAIT_V(2); PG8_BAR;
    PG8_STAGE(PG8_SB(1, 0), cB + kstep, voffB); PG8_STAGE(PG8_SA(1, 0), cA + kstep, voffA); PG8_STAGE(PG8_SB(1, 1), cB + hB + kstep, voffB);
    PG8_WAIT_V(6); PG8_BAR;
    for (;;) {
        const bool has_next = S.next(ui + 1, nxt);
        const char* nA = has_next ? (const char*)g.A + (size_t)nxt.pm * tA : cA; const char* nB = has_next ? (const char*)g.Bt + (size_t)nxt.pn * tB : cB;
        for (int t = 0; t < nt; t += 2) {
            const bool last = (t == nt - 2);
            const char* a1 = cA + (size_t)(t + 1) * kstep;
            const char* a2 = last ? nA : cA + (size_t)(t + 2) * kstep; const char* b2 = last ? nB : cB + (size_t)(t + 2) * kstep;
            const char* a3 = a2 + kstep; const char* b3 = b2 + kstep;
            PG8_LDB(B0, 0, 0); PG8_LDB(B1, 0, 1); PG8_SCHED; PG8_LDA(At, 0, 0); PG8_STAGE(PG8_SA(1, 1), a1 + hA, voffA);
            PG8_WAIT_V(8); PG8_WAIT_L(0); PG8_BAR; PG8_MMA(0, 0, At, B0); PG8_MMA(0, 1, At, B1); PG8_BAR; PG8_SCHED;
            PG8_LDA(At, 0, 1); PG8_STAGE(PG8_SB(0, 0), b2, voffB); PG8_STAGE(PG8_SB(0, 1), b2 + hB, voffB); PG8_STAGE(PG8_SA(0, 0), a2, voffA);
            PG8_WAIT_V(8); PG8_WAIT_L(0); PG8_BAR; PG8_MMA(1, 0, At, B0); PG8_MMA(1, 1, At, B1); PG8_BAR; PG8_SCHED;
            PG8_LDB(B0, 1, 0); PG8_LDB(B1, 1, 1); PG8_SCHED; PG8_LDA(At, 1, 0); PG8_STAGE(PG8_SA(0, 1), a2 + hA, voffA);
            PG8_WAIT_V(8); PG8_WAIT_L(0); PG8_BAR; PG8_MMA(0, 0, At, B0); PG8_MMA(0, 1, At, B1); PG8_BAR; PG8_SCHED;
            PG8_LDA(At, 1, 1); PG8_STAGE(PG8_SB(1, 0), b3, voffB); PG8_STAGE(PG8_SB(1, 1), b3 + hB, voffB); PG8_STAGE(PG8_SA(1, 0), a3, voffA);
            PG8_WAIT_V(8); PG8_WAIT_L(0); PG8_BAR; PG8_MMA(1, 0, At, B0); PG8_MMA(1, 1, At, B1); PG8_BAR; PG8_SCHED;
        }
        if (wr == 0) PG8_BAR;
        E(acc, cur, wr, wc, fr, fq);
        if (!has_next) break;
#pragma unroll
        for (int a = 0; a < 2; ++a)
#pragma unroll
            for (int b = 0; b < 2; ++b)
#pragma unroll
                for (int m = 0; m < 4; ++m)
#pragma unroll
                    for (int n = 0; n < 2; ++n) acc[a][b][m][n] = (f32x4){0.f, 0.f, 0.f, 0.f};
        cur = nxt; cA = nA; cB = nB; ++ui;
        if (wr == 1) PG8_BAR;
    }
    PG8_WAIT_V(0);
    PG8_BAR;
#undef PG8_SA
#undef PG8_SB
#undef PG8_STAGE
#undef PG8_LDA
#undef PG8_LDB
#undef PG8_MMA
#undef PG8_WAIT_V
#undef PG8_WAIT_L
#undef PG8_BAR
#undef PG8_SCHED
}
}

namespace att {
constexpr int NW = 8, QBLK = 32, KVBLK = 64;
constexpr float SCALE = 0.10206207261596575f;
constexpr float THR = 8.f;
constexpr size_t SHM_V = KVBLK * 128 * 2, SHM_K = KVBLK * 128 * 2;
#define KSWZ(row, colB) ((row) * 256 + ((colB) ^ (((row) & 15) << 4)))
#define SBAR() __builtin_amdgcn_sched_barrier(0)
__device__ __forceinline__ int crow(int r, int hi) { return (r & 3) + 8 * (r >> 2) + 4 * hi; }
__device__ __forceinline__ unsigned cvtpk(float lo, float hi) { unsigned r; asm volatile("v_cvt_pk_bf16_f32 %0, %1, %2" : "=v"(r) : "v"(lo), "v"(hi)); return r; }

constexpr float THRL = THR * 1.4426950408889634f;
__device__ __forceinline__ void partialSM(f32x16& p0, f32x16& p1, float& mhat, f32x16& negm, float& alpha) {
    float pmax = p0[0];
#pragma unroll
    for (int r = 1; r < 16; ++r) pmax = fmaxf(pmax, p0[r]);
#pragma unroll
    for (int r = 0; r < 16; ++r) pmax = fmaxf(pmax, p1[r]);
    { auto rr = __builtin_amdgcn_permlane32_swap(__float_as_uint(pmax), __float_as_uint(pmax), false, false);
      pmax = fmaxf(__uint_as_float(rr[0]), __uint_as_float(rr[1])); }
    if (__builtin_expect(__all(pmax <= THRL), 1)) { alpha = 1.f; }
    else { const float dl = fmaxf(pmax, 0.f); mhat += dl;
#pragma unroll
        for (int r = 0; r < 16; ++r) { p0[r] -= dl; p1[r] -= dl; }
#pragma unroll
        for (int r = 0; r < 16; ++r) negm[r] = -mhat;
        alpha = __builtin_amdgcn_exp2f(-dl); }
    asm volatile("" : "+v"(negm));
#pragma unroll
    for (int r = 0; r < 16; ++r) p0[r] = __builtin_amdgcn_exp2f(p0[r]);
}
__device__ __forceinline__ void finishSM(f32x16& p0, f32x16& p1, float alpha, float& l_reg, bf16x8& pa0, bf16x8& pa1, bf16x8& pa2, bf16x8& pa3) {
#pragma unroll
    for (int r = 0; r < 16; ++r) p1[r] = __builtin_amdgcn_exp2f(p1[r]);
    float ps, psa = 0, psb = 0, psc = 0, psd = 0;
#pragma unroll
    for (int r = 0; r < 16; r += 4) { psa += p0[r]; psb += p0[r + 1]; psc += p0[r + 2]; psd += p0[r + 3]; }
#pragma unroll
    for (int r = 0; r < 16; r += 4) { psa += p1[r]; psb += p1[r + 1]; psc += p1[r + 2]; psd += p1[r + 3]; }
    ps = (psa + psb) + (psc + psd);
    { auto rr = __builtin_amdgcn_permlane32_swap(__float_as_uint(ps), __float_as_uint(ps), false, false);
      ps = __uint_as_float(rr[0]) + __uint_as_float(rr[1]); }
    l_reg = l_reg * alpha + ps;
#define PK4(P, BASE, OUT) do { unsigned a0 = cvtpk(P[BASE + 0], P[BASE + 1]), a1 = cvtpk(P[BASE + 2], P[BASE + 3]);   \
    unsigned b0 = cvtpk(P[BASE + 4], P[BASE + 5]), b1 = cvtpk(P[BASE + 6], P[BASE + 7]);                              \
    auto r0 = __builtin_amdgcn_permlane32_swap(a0, b0, false, false); auto r1 = __builtin_amdgcn_permlane32_swap(a1, b1, false, false); \
    u32x4 w = {r0[0], r1[0], r0[1], r1[1]}; OUT = *reinterpret_cast<bf16x8*>(&w); } while (0)
    PK4(p0, 0, pa0); PK4(p0, 8, pa1); PK4(p1, 0, pa2); PK4(p1, 8, pa3);
#undef PK4
}
__device__ __forceinline__ void qkt(f32x16& p0, f32x16& p1, const char* Ks, const bf16x8* qr, const f32x16& negm, int r32, int hi) {
#pragma unroll
    for (int d0 = 0; d0 < 6; ++d0) { int cb = (d0 * 16 + hi * 8) * 2;
        bf16x8 b0 = *reinterpret_cast<const bf16x8*>(Ks + KSWZ(r32, cb));
        bf16x8 b1 = *reinterpret_cast<const bf16x8*>(Ks + KSWZ(32 + r32, cb));
        if (d0 == 0) { p0 = __builtin_amdgcn_mfma_f32_32x32x16_bf16(b0, qr[0], negm, 0, 0, 0); p1 = __builtin_amdgcn_mfma_f32_32x32x16_bf16(b1, qr[0], negm, 0, 0, 0); }
        else { p0 = __builtin_amdgcn_mfma_f32_32x32x16_bf16(b0, qr[d0], p0, 0, 0, 0); p1 = __builtin_amdgcn_mfma_f32_32x32x16_bf16(b1, qr[d0], p1, 0, 0, 0); } }
}
__device__ __forceinline__ int v_st(int k, int c) { const int kk = (k & ~0xC) | ((k & 4) << 1) | ((k & 8) >> 1); return ((kk >> 3) * 4 + (c >> 5)) * 512 + ((kk & 7) * 32 + (c & 31)) * 2; }
__device__ __forceinline__ int v_rd_base(int lane) { return ((lane & 3) << 3) | (((lane >> 2) & 3) << 6) | (((lane >> 4) & 1) << 5) | (((lane >> 5) & 1) << 8); }
constexpr int v_rd_off(int d0, int ks, int half) { return d0 * 512 + ks * 4096 + half * 2048; }
template <int OFF> __device__ __forceinline__ s16x4 tr_read(int vb) {
    s16x4 r; asm volatile("ds_read_b64_tr_b16 %0, %1 offset:%2" : "=&v"(r) : "v"(vb), "i"(OFF) : "memory"); return r;
}
template <int D0> __device__ __forceinline__ void pv_one(f32x16& od, int vb, bf16x8 pa0, bf16x8 pa1, bf16x8 pa2, bf16x8 pa3) {
    const s16x4 l0 = tr_read<v_rd_off(D0, 0, 0)>(vb), h0 = tr_read<v_rd_off(D0, 0, 1)>(vb), l1 = tr_read<v_rd_off(D0, 1, 0)>(vb), h1 = tr_read<v_rd_off(D0, 1, 1)>(vb);
    const s16x4 l2 = tr_read<v_rd_off(D0, 2, 0)>(vb), h2 = tr_read<v_rd_off(D0, 2, 1)>(vb), l3 = tr_read<v_rd_off(D0, 3, 0)>(vb), h3 = tr_read<v_rd_off(D0, 3, 1)>(vb);
    asm volatile("s_waitcnt lgkmcnt(0)" ::: "memory"); SBAR();
#define PK(L, H) (bf16x8){L[0], L[1], L[2], L[3], H[0], H[1], H[2], H[3]}
    od = __builtin_amdgcn_mfma_f32_32x32x16_bf16(pa0, PK(l0, h0), od, 0, 0, 0);
    od = __builtin_amdgcn_mfma_f32_32x32x16_bf16(pa1, PK(l1, h1), od, 0, 0, 0);
    od = __builtin_amdgcn_mfma_f32_32x32x16_bf16(pa2, PK(l2, h2), od, 0, 0, 0);
    od = __builtin_amdgcn_mfma_f32_32x32x16_bf16(pa3, PK(l3, h3), od, 0, 0, 0);
#undef PK
}
__device__ __forceinline__ void pv_d0(f32x16* o, int vb, bf16x8 pa0, bf16x8 pa1, bf16x8 pa2, bf16x8 pa3) {
    pv_one<0>(o[0], vb, pa0, pa1, pa2, pa3); pv_one<1>(o[1], vb, pa0, pa1, pa2, pa3);
}

__device__ __forceinline__ void attn_body(const bf16_t* Qb, const bf16_t* __restrict__ Kh, const bf16_t* __restrict__ Vh, bf16_t* Ob, int seq, char* lds) {
    int tid = threadIdx.x; asm volatile("" : "+v"(tid));
    const int wid = tid >> 6, lane = tid & 63, r32 = lane & 31, hi = lane >> 5;
    char* V_lds = lds; char* K_lds = lds + 2 * SHM_V;
    float* ws = (float*)(lds + 2 * SHM_V + 2 * SHM_K) + wid * 64; float* li_l = ws; float* al_l = ws + 32;
    float mhat = 0.f, l_reg = 0; f32x16 o[2] = {}; bf16x8 qr[6]; f32x16 negm = f32x16{}; asm volatile("" : "+v"(negm));
    const bf16_t* Qw = Qb + (long)(wid * QBLK + r32) * LDQ + hi * 8;
#pragma unroll
    for (int d0 = 0; d0 < 6; ++d0) qr[d0] = *reinterpret_cast<const bf16x8*>(Qw + d0 * 16);
    const int kc0 = tid, kc1 = (tid < 256) ? 512 + tid : tid;
    const int kr0 = kc0 / 12, kcc0 = kc0 % 12, kr1 = kc1 / 12, kcc1 = kc1 % 12;
    const bool k1ok = tid < 256;
    const int vr = tid >> 3, vc = (tid & 7) * 8;
    const int kst0 = KSWZ(kr0, kcc0 * 16), kst1 = KSWZ(kr1, kcc1 * 16), vst = v_st(vr, vc);
    const int vb0 = (int)(uintptr_t)V_lds + v_rd_base(lane);
    struct { bf16x8 v, k0, k1; } sr_[2];
#define SLOAD(i, kk0) do { sr_[i].v = *reinterpret_cast<const bf16x8*>(&Vh[(long)((kk0) + vr) * LDKV + vc]); \
    sr_[i].k0 = *reinterpret_cast<const bf16x8*>(&Kh[(long)((kk0) + kr0) * LDKV + kcc0 * 8]); \
    sr_[i].k1 = *reinterpret_cast<const bf16x8*>(&Kh[(long)((kk0) + kr1) * LDKV + kcc1 * 8]); } while (0)
#define SWRITE(b, i) do { *(bf16x8*)(V_lds + (b) * SHM_V + vst) = sr_[i].v; \
    *(bf16x8*)(K_lds + (b) * SHM_K + kst0) = sr_[i].k0; \
    if (k1ok) *(bf16x8*)(K_lds + (b) * SHM_K + kst1) = sr_[i].k1; } while (0)
#define SWAIT() asm volatile("s_waitcnt vmcnt(3)" ::: "memory")
#define RESC(a) do { if (__any((a) < 1.f)) { if (hi == 0) al_l[r32] = (a); asm volatile("s_waitcnt lgkmcnt(0)" ::: "memory"); \
    _Pragma("unroll") for (int d = 0; d < 2; ++d) _Pragma("unroll") for (int r = 0; r < 16; ++r) o[d][r] *= al_l[crow(r, hi)]; } } while (0)
    f32x16 pA0, pA1, pB0, pB1; float alA, alB; bf16x8 pa0, pa1, pa2, pa3; const int NT = seq / KVBLK;
    constexpr int SE = 0, SO = 1;
    SLOAD(SE, 0); asm volatile("s_waitcnt vmcnt(0)" ::: "memory"); SWRITE(0, SE); __syncthreads();
    qkt(pA0, pA1, K_lds, qr, negm, r32, hi); partialSM(pA0, pA1, mhat, negm, alA);
    SLOAD(SO, KVBLK); SLOAD(SE, 2 * KVBLK);
    SWAIT(); SWRITE(1, SO); __syncthreads();
    for (int j = 1; j + 1 < NT; j += 2) {
        SBAR(); qkt(pB0, pB1, K_lds + SHM_K, qr, negm, r32, hi);
        finishSM(pA0, pA1, alA, l_reg, pa0, pa1, pa2, pa3); SBAR();
        SLOAD(SO, (j + 2) * KVBLK); SBAR();
        pv_d0(o, vb0, pa0, pa1, pa2, pa3); partialSM(pB0, pB1, mhat, negm, alB);
        __syncthreads(); SWAIT(); SWRITE(0, SE);
        RESC(alB); __syncthreads();
        SBAR(); qkt(pA0, pA1, K_lds, qr, negm, r32, hi);
        finishSM(pB0, pB1, alB, l_reg, pa0, pa1, pa2, pa3); SBAR();
        { const int jn = (j + 3 < NT) ? (j + 3) : (NT - 1); SLOAD(SE, jn * KVBLK); } SBAR();
        pv_d0(o, vb0 + (int)SHM_V, pa0, pa1, pa2, pa3); partialSM(pA0, pA1, mhat, negm, alA);
        __syncthreads(); SWAIT(); SWRITE(1, SO);
        RESC(alA); __syncthreads();
    }
    SBAR(); qkt(pB0, pB1, K_lds + SHM_K, qr, negm, r32, hi);
    finishSM(pA0, pA1, alA, l_reg, pa0, pa1, pa2, pa3); SBAR();
    pv_d0(o, vb0, pa0, pa1, pa2, pa3); partialSM(pB0, pB1, mhat, negm, alB);
    __syncthreads(); RESC(alB);
    finishSM(pB0, pB1, alB, l_reg, pa0, pa1, pa2, pa3); SBAR();
    pv_d0(o, vb0 + (int)SHM_V, pa0, pa1, pa2, pa3);
    if (hi == 0) li_l[r32] = l_reg; asm volatile("s_waitcnt lgkmcnt(0)" ::: "memory");
    float rli[16];
#pragma unroll
    for (int r = 0; r < 16; ++r) rli[r] = __builtin_amdgcn_rcpf(li_l[crow(r, hi)]);
    bf16_t* Ow = Ob + (long)(wid * QBLK) * LDQ;
#pragma unroll
    for (int r = 0; r < 16; ++r) { int orow = crow(r, hi);
#pragma unroll
        for (int d0 = 0; d0 < 2; ++d0) Ow[(long)orow * LDQ + d0 * 32 + r32] = f2bf(o[d0][r] * rli[r]); }
#undef SLOAD
#undef SWRITE
#undef SWAIT
#undef RESC
}

__device__ __forceinline__ bool partialSM_abs(f32x16& p0, f32x16& p1, float& mhat, float& alpha) {
    float pmax = p0[0], pmb = p1[0];
#pragma unroll
    for (int r = 1; r < 16; ++r) { pmax = fmaxf(pmax, p0[r]); pmb = fmaxf(pmb, p1[r]); }
    pmax = fmaxf(pmax, pmb);
    { auto rr = __builtin_amdgcn_permlane32_swap(__float_as_uint(pmax), __float_as_uint(pmax), false, false);
      pmax = fmaxf(__uint_as_float(rr[0]), __uint_as_float(rr[1])); }
    alpha = 1.f;
    const bool slow = !__all((pmax <= THRL) && (mhat == 0.f));
    if (__builtin_expect(slow, 0)) {
        const float rel = pmax - mhat;
        if (rel > THRL) { mhat += rel; alpha = __builtin_amdgcn_exp2f(-rel); }
#pragma unroll
        for (int r = 0; r < 16; ++r) { p0[r] -= mhat; p1[r] -= mhat; }
    }
#pragma unroll
    for (int r = 0; r < 16; ++r) p0[r] = __builtin_amdgcn_exp2f(p0[r]);
    return slow;
}
constexpr int PP_LDS = 3 * (int)SHM_K + 3 * (int)SHM_V + 8 * 64 * 4;
__device__ __forceinline__ void attn_pp(const bf16_t* Qb, const bf16_t* __restrict__ Kh, const bf16_t* __restrict__ Vh, bf16_t* Ob, const int ldo, int seq, char* lds) {
    int tid = threadIdx.x; asm volatile("" : "+v"(tid));
    const int wid = tid >> 6, lane = tid & 63, r32 = lane & 31, hi = lane >> 5;
    const int half = __builtin_amdgcn_readfirstlane(wid >> 2);
    char* K_lds = lds; char* V_lds = lds + 3 * SHM_K;
    float* ws = (float*)(lds + 3 * SHM_K + 3 * SHM_V) + wid * 64; float* li_l = ws; float* al_l = ws + 32;
    float mhat = 0.f, l_reg = 0; f32x16 o[2] = {}; bf16x8 qr[6];
    const bf16_t* Qw = Qb + (long)(wid * QBLK + r32) * LDQ + hi * 8;
#pragma unroll
    for (int d0 = 0; d0 < 6; ++d0) qr[d0] = *reinterpret_cast<const bf16x8*>(Qw + d0 * 16);
    const int kc0 = tid, kc1 = (tid < 256) ? 512 + tid : tid;
    const int kr0 = kc0 / 12, kcc0 = kc0 % 12, kr1 = kc1 / 12, kcc1 = kc1 % 12;
    const bool k1ok = tid < 256;
    const int vr = tid >> 3, vc = (tid & 7) * 8;
    const int kst0 = KSWZ(kr0, kcc0 * 16), kst1 = KSWZ(kr1, kcc1 * 16), vst = v_st(vr, vc);
    const int vb0 = (int)(uintptr_t)V_lds + v_rd_base(lane);
    bf16x8 gk0, gk1, gv;
    bf16x8 kf[12];
    s16x4 vl[2][4], vh[2][4];
#define KREAD(slot) do { const char* Ks_ = K_lds + (slot) * (int)SHM_K; _Pragma("unroll") for (int d0 = 0; d0 < 6; ++d0) { const int cb = (d0 * 16 + hi * 8) * 2; \
    kf[2 * d0] = *reinterpret_cast<const bf16x8*>(Ks_ + KSWZ(r32, cb)); kf[2 * d0 + 1] = *reinterpret_cast<const bf16x8*>(Ks_ + KSWZ(32 + r32, cb)); } } while (0)
#define VISSUE0(vb_) do { const int vb__ = (vb_); \
    vl[0][0] = tr_read<v_rd_off(0, 0, 0)>(vb__); vh[0][0] = tr_read<v_rd_off(0, 0, 1)>(vb__); vl[0][1] = tr_read<v_rd_off(0, 1, 0)>(vb__); vh[0][1] = tr_read<v_rd_off(0, 1, 1)>(vb__); \
    vl[0][2] = tr_read<v_rd_off(0, 2, 0)>(vb__); vh[0][2] = tr_read<v_rd_off(0, 2, 1)>(vb__); vl[0][3] = tr_read<v_rd_off(0, 3, 0)>(vb__); vh[0][3] = tr_read<v_rd_off(0, 3, 1)>(vb__); } while (0)
#define VISSUE1(vb_) do { const int vb__ = (vb_); \
    vl[1][0] = tr_read<v_rd_off(1, 0, 0)>(vb__); vh[1][0] = tr_read<v_rd_off(1, 0, 1)>(vb__); vl[1][1] = tr_read<v_rd_off(1, 1, 0)>(vb__); vh[1][1] = tr_read<v_rd_off(1, 1, 1)>(vb__); \
    vl[1][2] = tr_read<v_rd_off(1, 2, 0)>(vb__); vh[1][2] = tr_read<v_rd_off(1, 2, 1)>(vb__); vl[1][3] = tr_read<v_rd_off(1, 3, 0)>(vb__); vh[1][3] = tr_read<v_rd_off(1, 3, 1)>(vb__); } while (0)
#define VPK(d, k) (bf16x8){vl[d][k][0], vl[d][k][1], vl[d][k][2], vl[d][k][3], vh[d][k][0], vh[d][k][1], vh[d][k][2], vh[d][k][3]}
#define PVMMA0() do { asm volatile("s_waitcnt lgkmcnt(8)" ::: "memory"); SBAR(); \
    o[0] = __builtin_amdgcn_mfma_f32_32x32x16_bf16(pa0, VPK(0, 0), o[0], 0, 0, 0); o[0] = __builtin_amdgcn_mfma_f32_32x32x16_bf16(pa1, VPK(0, 1), o[0], 0, 0, 0); \
    o[0] = __builtin_amdgcn_mfma_f32_32x32x16_bf16(pa2, VPK(0, 2), o[0], 0, 0, 0); o[0] = __builtin_amdgcn_mfma_f32_32x32x16_bf16(pa3, VPK(0, 3), o[0], 0, 0, 0); SBAR(); } while (0)
#define PVMMA1() do { asm volatile("s_waitcnt lgkmcnt(0)" ::: "memory"); SBAR(); \
    o[1] = __builtin_amdgcn_mfma_f32_32x32x16_bf16(pa0, VPK(1, 0), o[1], 0, 0, 0); o[1] = __builtin_amdgcn_mfma_f32_32x32x16_bf16(pa1, VPK(1, 1), o[1], 0, 0, 0); \
    o[1] = __builtin_amdgcn_mfma_f32_32x32x16_bf16(pa2, VPK(1, 2), o[1], 0, 0, 0); o[1] = __builtin_amdgcn_mfma_f32_32x32x16_bf16(pa3, VPK(1, 3), o[1], 0, 0, 0); } while (0)
#define QKREG(D0A, D0B) do { _Pragma("unroll") for (int d0 = (D0A); d0 < (D0B); ++d0) { p0 = __builtin_amdgcn_mfma_f32_32x32x16_bf16(kf[2 * d0], qr[d0], p0, 0, 0, 0); p1 = __builtin_amdgcn_mfma_f32_32x32x16_bf16(kf[2 * d0 + 1], qr[d0], p1, 0, 0, 0); } } while (0)
#define LOADK(kk0) do { gk0 = *reinterpret_cast<const bf16x8*>(&Kh[(long)((kk0) + kr0) * LDKV + kcc0 * 8]); gk1 = *reinterpret_cast<const bf16x8*>(&Kh[(long)((kk0) + kr1) * LDKV + kcc1 * 8]); } while (0)
#define LOADV(kk0) do { gv = *reinterpret_cast<const bf16x8*>(&Vh[(long)((kk0) + vr) * LDKV + vc]); } while (0)
#define WRITEK(slot) do { *(bf16x8*)(K_lds + (slot) * (int)SHM_K + kst0) = gk0; if (k1ok) *(bf16x8*)(K_lds + (slot) * (int)SHM_K + kst1) = gk1; } while (0)
#define WRITEV(slot) do { *(bf16x8*)(V_lds + (slot) * (int)SHM_V + vst) = gv; } while (0)
#define BARRIER() do { asm volatile("s_waitcnt lgkmcnt(0)" ::: "memory"); __builtin_amdgcn_s_barrier(); asm volatile("" ::: "memory"); SBAR(); } while (0)
#define RESC(a) do { if (__any((a) < 1.f)) { if (hi == 0) al_l[r32] = (a); asm volatile("s_waitcnt lgkmcnt(0)" ::: "memory"); \
    _Pragma("unroll") for (int d = 0; d < 2; ++d) _Pragma("unroll") for (int r = 0; r < 16; ++r) o[d][r] *= al_l[crow(r, hi)]; } } while (0)
    const int NT = seq / KVBLK;
    LOADK(0); asm volatile("s_waitcnt vmcnt(0)" ::: "memory"); WRITEK(0);
    LOADK(KVBLK); asm volatile("s_waitcnt vmcnt(0)" ::: "memory"); WRITEK(1);
    BARRIER();
    KREAD(0);
    LOADK(2 * KVBLK); LOADV(0);
    if (half == 1) BARRIER();
    f32x16 p0, p1; float alpha; bf16x8 pa0, pa1, pa2, pa3;
    int s0 = 0, s1 = 1, s2 = 2;
    for (int i = 0; i < NT; ++i) {
        if (i > 0) VISSUE0(vb0 + s2 * (int)SHM_V);
        SBAR();
        p0 = f32x16{}; p1 = f32x16{};
        QKREG(0, 3);
        SBAR();
        if (i > 0) VISSUE1(vb0 + s2 * (int)SHM_V);
        SBAR();
        QKREG(3, 6);
        SBAR();
        if (i > 0) { PVMMA0(); PVMMA1(); }
        asm volatile("s_waitcnt vmcnt(0)" ::: "memory");
        WRITEK(s2); WRITEV(s0);
        BARRIER();
        if (i + 1 < NT) KREAD(s1);
        { const int tk = (i + 3 < NT) ? i + 3 : NT - 1, tv = (i + 1 < NT) ? i + 1 : NT - 1; LOADK(tk * KVBLK); LOADV(tv * KVBLK); }
        const bool slow_ = partialSM_abs(p0, p1, mhat, alpha);
        finishSM(p0, p1, alpha, l_reg, pa0, pa1, pa2, pa3);
        if (slow_) RESC(alpha);
        BARRIER();
        { const int t = s0; s0 = s1; s1 = s2; s2 = t; }
    }
    VISSUE0(vb0 + s2 * (int)SHM_V); VISSUE1(vb0 + s2 * (int)SHM_V); PVMMA0(); PVMMA1();
    BARRIER();
    if (half == 0) BARRIER();
    if (hi == 0) li_l[r32] = l_reg; asm volatile("s_waitcnt lgkmcnt(0)" ::: "memory");
    float rli[16];
#pragma unroll
    for (int r = 0; r < 16; ++r) rli[r] = __builtin_amdgcn_rcpf(li_l[crow(r, hi)]);
    bf16_t* Ow = Ob + (long)(wid * QBLK) * ldo;
#pragma unroll
    for (int r = 0; r < 16; ++r) { int orow = crow(r, hi);
#pragma unroll
        for (int d0 = 0; d0 < 2; ++d0) Ow[(long)orow * ldo + d0 * 32 + r32] = f2bf(o[d0][r] * rli[r]); }
#undef KREAD
#undef VISSUE0
#undef VISSUE1
#undef VPK
#undef PVMMA0
#undef PVMMA1
#undef QKREG
#undef LOADK
#undef LOADV
#undef WRITEK
#undef WRITEV
#undef BARRIER
#undef RESC
}
#undef KSWZ
#undef SBAR
}

__device__ __forceinline__ float wsrc(const Args& a, int mat, int l, int k, int n) {
    switch (mat) {
    case 0: { const int s = (n < 416) ? n : ((n < 512) ? -1 : n - 96);
              return s < 0 ? 0.f : a.in[2][((size_t)l * DM + k) * INC + s] * a.in[1][l * DM + k]; }
    case 1: return a.in[4][((size_t)l * 256 + k) * 768 + n] * a.in[3][l * 256 + k];
    case 2: { const float g = a.in[5][l * 128 + k];
              if (n < 768) { const int h = n / 96, j = n % 96; return j < 64 ? a.in[6][((size_t)l * 128 + k) * 512 + h * 64 + j] * g : 0.f; }
              return a.in[7][((size_t)l * 128 + k) * 512 + (n - 768)] * g; }
    case 3: return a.in[10][((size_t)l * 512 + k) * 1024 + n];
    case 4: { const int s = ((n >> 2) & 1) * 1024 + (n >> 3) * 4 + (n & 3); return a.in[19][((size_t)l * 512 + k) * 2048 + s]; }
    case 5: return a.in[20][((size_t)l * 1024 + k) * 1024 + n];
    case 6: { const int j = (n >> 3) * 4 + (n & 3); const float* w = ((n >> 2) & 1) ? a.in[23] : a.in[22];
              return w[((size_t)l * 1024 + k) * DFF + j] * a.in[21][l * 1024 + k]; }
    default: return a.in[24][((size_t)l * DFF + k) * 1024 + n];
    }
}
__device__ __forceinline__ void transpose_item(const Args& a, int mat, int l, int Kd, int Nd, bf16_t* WT, LAS float* scr, int item, int lane) {
    const int nblk = Nd / 32, kb = item / nblk, nb = item % nblk, k0 = 64 * kb, n0 = 32 * nb;
    float tv[32];
#pragma unroll
    for (int i = 0; i < 32; ++i) tv[i] = wsrc(a, mat, l, k0 + 2 * i + (lane >> 5), n0 + (lane & 31));
#pragma unroll
    for (int i = 0; i < 32; ++i) scr[(2 * i + (lane >> 5)) * 33 + (lane & 31)] = tv[i];
    asm volatile("s_waitcnt lgkmcnt(0)" ::: "memory");
    const int c = lane & 7;
#pragma unroll
    for (int j = 0; j < 4; ++j) { const int n = (lane >> 3) + 8 * j; const LAS float* s = scr + (8 * c) * 33 + n;
        u32x4 o; o.x = cvt_pk_bf16(s[0 * 33], s[1 * 33]); o.y = cvt_pk_bf16(s[2 * 33], s[3 * 33]); o.z = cvt_pk_bf16(s[4 * 33], s[5 * 33]); o.w = cvt_pk_bf16(s[6 * 33], s[7 * 33]);
        *(u32x4*)(WT + (size_t)(n0 + n) * Kd + k0 + 8 * c) = o; }
    asm volatile("s_waitcnt lgkmcnt(0)" ::: "memory");
}
__device__ __forceinline__ void p0_prologue(const Args& a, LAS unsigned char* lds, int gw, int NGW, int wave, int lane) {
    LAS float* scr = (LAS float*)(lds + wave * 16384);
    constexpr int KD[8] = {1024, 256, 128, 512, 512, 1024, 1024, 2816};
    constexpr int ND[8] = {3072, 768, 1280, 1024, 2048, 1024, 5632, 1024};
    constexpr size_t WO[8] = {W0, W1, W2, W3, W4, W5, W6, W7};
    constexpr int IT[8] = {16 * 96, 4 * 24, 2 * 40, 8 * 32, 8 * 64, 16 * 32, 16 * 176, 44 * 32};
    constexpr int ITL = IT[0] + IT[1] + IT[2] + IT[3] + IT[4] + IT[5] + IT[6] + IT[7];
    for (int it = gw; it < DEPTH * ITL; it += NGW) {
        const int l = it / ITL; int r = it % ITL;
#pragma unroll
        for (int mt = 0; mt < 8; ++mt) {
            if (r >= 0 && r < IT[mt]) transpose_item(a, mt, l, KD[mt], ND[mt], (bf16_t*)(a.ws + WS_W + (size_t)l * W_LAYER + WO[mt]), scr, r, lane);
            r -= IT[mt];
        }
    }
    const int gt = gw * 64 + lane;
    if (gt < DEPTH * 2 * NG * ST) {
        const int ldg = gt / ST;
        const float lre = a.in[11][gt], lim = a.in[12][gt];
        const float dt = expf(a.in[13][ldg]);
        const float ar = lre * dt, ai = lim * dt;
        const float ea = expf(ar), cb = cosf(ai), sb = sinf(ai), sh = sinf(0.5f * ai);
        const float lbr = ea * cb, lbi = ea * sb;
        const float nr = expm1f(ar) * cb - 2.f * sh * sh, ni = ea * sb;
        const float den = 1.f / (lre * lre + lim * lim);
        const float cr = (nr * lre + ni * lim) * den, ci = (ni * lre - nr * lim) * den;
        ((f32x2*)(a.ws + WS_LAMB))[gt] = (f32x2){lbr, lbi};
        f32x2* bb = (f32x2*)(a.ws + WS_BBAR) + (size_t)gt * 16;
#pragma unroll
        for (int c = 0; c < 16; ++c) { const float br = a.in[14][(size_t)gt * 16 + c], bi = a.in[15][(size_t)gt * 16 + c];
            bb[c] = (f32x2){cr * br - ci * bi, cr * bi + ci * br}; }
    }
}

__device__ __forceinline__ void norm_row2(const float* xa, bf16_t* oa, const float* xb, bf16_t* ob, int lane) {
    const f32x4* ra = (const f32x4*)xa + lane; const f32x4* rb = (const f32x4*)xb + lane;
    f32x4 va[4], vb[4]; float sa = 0.f, sb = 0.f;
#pragma unroll
    for (int j = 0; j < 4; ++j) { va[j] = ra[64 * j]; vb[j] = rb[64 * j]; }
#pragma unroll
    for (int j = 0; j < 4; ++j) { sa += (va[j].x * va[j].x + va[j].y * va[j].y) + (va[j].z * va[j].z + va[j].w * va[j].w); sb += (vb[j].x * vb[j].x + vb[j].y * vb[j].y) + (vb[j].z * vb[j].z + vb[j].w * vb[j].w); }
#pragma unroll
    for (int o = 1; o < 64; o <<= 1) { sa += __shfl_xor(sa, o); sb += __shfl_xor(sb, o); }
    const float ia = 1.f / sqrtf(sa * (1.f / DM) + EPS), ib = 1.f / sqrtf(sb * (1.f / DM) + EPS);
    u32x2* pa = (u32x2*)oa + lane; u32x2* pb = (u32x2*)ob + lane;
#pragma unroll
    for (int j = 0; j < 4; ++j) { u32x2 w; w.x = cvt_pk_bf16(va[j].x * ia, va[j].y * ia); w.y = cvt_pk_bf16(va[j].z * ia, va[j].w * ia); pa[64 * j] = w;
        u32x2 z; z.x = cvt_pk_bf16(vb[j].x * ib, vb[j].y * ib); z.y = cvt_pk_bf16(vb[j].z * ib, vb[j].w * ib); pb[64 * j] = z; }
}
__device__ __forceinline__ void norm_row(const float* xrow, bf16_t* orow, int lane) {
    const f32x4* xr = (const f32x4*)xrow + lane;
    f32x4 v[4]; float s = 0.f;
#pragma unroll
    for (int j = 0; j < 4; ++j) { v[j] = xr[64 * j]; s += (v[j].x * v[j].x + v[j].y * v[j].y) + (v[j].z * v[j].z + v[j].w * v[j].w); }
    const float rinv = 1.f / sqrtf(wave_sum(s) * (1.f / DM) + EPS);
    u32x2* o8 = (u32x2*)orow + lane;
#pragma unroll
    for (int j = 0; j < 4; ++j) { u32x2 w; w.x = cvt_pk_bf16(v[j].x * rinv, v[j].y * rinv); w.y = cvt_pk_bf16(v[j].z * rinv, v[j].w * rinv); o8[64 * j] = w; }
}

__device__ __forceinline__ void sincos_d(double a, float& s, float& c) {
    const double TWO_OVER_PI = 0.63661977236758134308, PIO2_HI = 1.57079632679489655800e+00, PIO2_LO = 6.12323399573676603587e-17;
    const double kq = rint(a * TWO_OVER_PI);
    double y = fma(-kq, PIO2_HI, a); y = fma(-kq, PIO2_LO, y);
    const double y2 = y * y;
    double sp = 1.0 / 6227020800.0; sp = fma(sp, y2, -1.0 / 39916800.0); sp = fma(sp, y2, 1.0 / 362880.0); sp = fma(sp, y2, -1.0 / 5040.0); sp = fma(sp, y2, 1.0 / 120.0); sp = fma(sp, y2, -1.0 / 6.0); sp = fma(sp, y2, 1.0);
    const double sy = y * sp;
    double cp = 1.0 / 479001600.0; cp = fma(cp, y2, -1.0 / 3628800.0); cp = fma(cp, y2, 1.0 / 40320.0); cp = fma(cp, y2, -1.0 / 720.0); cp = fma(cp, y2, 1.0 / 24.0); cp = fma(cp, y2, -0.5); cp = fma(cp, y2, 1.0);
    const int q = ((int)kq) & 3;
    const double ss = (q == 0) ? sy : (q == 1) ? cp : (q == 2) ? -sy : -cp;
    const double cc = (q == 0) ? cp : (q == 1) ? -sy : (q == 2) ? -cp : sy;
    s = (float)ss; c = (float)cc;
}

__device__ __forceinline__ void unpack8(const u32x4 w, float* v) { v[0] = bf_lo(w.x); v[1] = bf_hi(w.x); v[2] = bf_lo(w.y); v[3] = bf_hi(w.y); v[4] = bf_lo(w.z); v[5] = bf_hi(w.z); v[6] = bf_lo(w.w); v[7] = bf_hi(w.w); }
__device__ __forceinline__ u32x4 pack8(const float* v) { u32x4 w; w.x = cvt_pk_bf16(v[0], v[1]); w.y = cvt_pk_bf16(v[2], v[3]); w.z = cvt_pk_bf16(v[4], v[5]); w.w = cvt_pk_bf16(v[6], v[7]); return w; }
__device__ __forceinline__ void postproc_row(const Args& a, int l, int row, int lane) {
    const bf16_t* P = (const bf16_t*)(a.ws + WS_PROJ) + (size_t)row * PROJ_N;
    bf16_t* Qr = (bf16_t*)(a.ws + WS_Q) + (size_t)row * LDQ; bf16_t* KVr = (bf16_t*)(a.ws + WS_KV) + (size_t)row * LDKV;
    const int sub = lane & 7, head = lane >> 3; const bool rp = sub < 2;
    const u32x2 cqw = *(const u32x2*)(P + lane * 4);
    const unsigned ckw = *(const unsigned*)(P + 256 + lane * 2);
    const u32x4 q0w = *(const u32x4*)(Qr + head * 96 + sub * 8);
    const u32x4 k0w = *(const u32x4*)(KVr + head * 96 + sub * 8);
    u32x4 q1w = {0, 0, 0, 0}, q2w = {0, 0, 0, 0}, r1w = {0, 0, 0, 0}, r2w = {0, 0, 0, 0};
    if (rp) { q1w = *(const u32x4*)(Qr + head * 96 + 64 + sub * 8); q2w = *(const u32x4*)(Qr + head * 96 + 80 + sub * 8);
              r1w = *(const u32x4*)(P + 384 + sub * 8); r2w = *(const u32x4*)(P + 384 + 16 + sub * 8); }
    u32x4* vp = (u32x4*)(KVr + 768 + lane * 8); const u32x4 vw = *vp;
    const f32x4 gq0a = *(const f32x4*)(a.in[8] + l * 96 + sub * 8), gq0b = *(const f32x4*)(a.in[8] + l * 96 + sub * 8 + 4);
    const f32x4 gk0a = *(const f32x4*)(a.in[9] + l * 96 + sub * 8), gk0b = *(const f32x4*)(a.in[9] + l * 96 + sub * 8 + 4);
    const int so = rp ? sub * 8 : 0;
    const f32x4 gq1a = *(const f32x4*)(a.in[8] + l * 96 + 64 + so), gq1b = *(const f32x4*)(a.in[8] + l * 96 + 64 + so + 4);
    const f32x4 gq2a = *(const f32x4*)(a.in[8] + l * 96 + 80 + so), gq2b = *(const f32x4*)(a.in[8] + l * 96 + 80 + so + 4);
    const f32x4 gk1a = *(const f32x4*)(a.in[9] + l * 96 + 64 + so), gk1b = *(const f32x4*)(a.in[9] + l * 96 + 64 + so + 4);
    const f32x4 gk2a = *(const f32x4*)(a.in[9] + l * 96 + 80 + so), gk2b = *(const f32x4*)(a.in[9] + l * 96 + 80 + so + 4);
    float s1 = bf_lo(cqw.x) * bf_lo(cqw.x) + bf_hi(cqw.x) * bf_hi(cqw.x) + bf_lo(cqw.y) * bf_lo(cqw.y) + bf_hi(cqw.y) * bf_hi(cqw.y);
    float s2 = bf_lo(ckw) * bf_lo(ckw) + bf_hi(ckw) * bf_hi(ckw);
#pragma unroll
    for (int o = 1; o < 64; o <<= 1) { s1 += __shfl_xor(s1, o); s2 += __shfl_xor(s2, o); }
    const float sq = 1.f / sqrtf(s1 * (1.f / 256.f) + EPS), skv = 1.f / sqrtf(s2 * (1.f / 128.f) + EPS);
    const int pos = row & (SEQ - 1);
    float cs[8], sn[8];
#pragma unroll
    for (int e = 0; e < 8; ++e) { cs[e] = 1.f; sn[e] = 0.f; }
    if (rp) {
#pragma unroll
        for (int e = 0; e < 8; ++e) { const int i3 = e & 3; const int i2 = sub * 2 + (e >> 2);
            const double base = (i3 == 0) ? 1.0 : (i3 == 1) ? 0.5623413251903491 : (i3 == 2) ? 0.31622776601683794 : 0.17782794100389228;
            const double sc = (i2 == 0) ? 1.0 : (i2 == 1) ? 0.1 : (i2 == 2) ? 0.01 : 0.001;
            const float invf = (float)(base * sc); const float ang = (float)pos * invf;
            sincos_d((double)ang, sn[e], cs[e]); } }
    float g0[8] = {gq0a.x, gq0a.y, gq0a.z, gq0a.w, gq0b.x, gq0b.y, gq0b.z, gq0b.w};
    float g1[8] = {gq1a.x, gq1a.y, gq1a.z, gq1a.w, gq1b.x, gq1b.y, gq1b.z, gq1b.w};
    float g2[8] = {gq2a.x, gq2a.y, gq2a.z, gq2a.w, gq2b.x, gq2b.y, gq2b.z, gq2b.w};
    { float v0[8], v1[8], v2[8]; unpack8(q0w, v0); unpack8(q1w, v1); unpack8(q2w, v2); float ss = 0.f;
#pragma unroll
      for (int e = 0; e < 8; ++e) { v0[e] *= sq; v1[e] *= sq; v2[e] *= sq; ss += v0[e] * v0[e] + v1[e] * v1[e] + v2[e] * v2[e]; }
      ss += __shfl_xor(ss, 1); ss += __shfl_xor(ss, 2); ss += __shfl_xor(ss, 4);
      const float rinv = 1.f / sqrtf(ss * (1.f / 96.f) + EPS) * (att::SCALE * 1.4426950408889634f);
#pragma unroll
      for (int e = 0; e < 8; ++e) { v0[e] *= rinv * g0[e]; const float x1 = v1[e] * rinv * g1[e], x2 = v2[e] * rinv * g2[e]; v1[e] = x1 * cs[e] - x2 * sn[e]; v2[e] = x2 * cs[e] + x1 * sn[e]; }
      *(u32x4*)(Qr + head * 96 + sub * 8) = pack8(v0);
      if (rp) { *(u32x4*)(Qr + head * 96 + 64 + sub * 8) = pack8(v1); *(u32x4*)(Qr + head * 96 + 80 + sub * 8) = pack8(v2); } }
    { float h0[8] = {gk0a.x, gk0a.y, gk0a.z, gk0a.w, gk0b.x, gk0b.y, gk0b.z, gk0b.w};
      float h1[8] = {gk1a.x, gk1a.y, gk1a.z, gk1a.w, gk1b.x, gk1b.y, gk1b.z, gk1b.w};
      float h2[8] = {gk2a.x, gk2a.y, gk2a.z, gk2a.w, gk2b.x, gk2b.y, gk2b.z, gk2b.w};
      float v0[8], v1[8], v2[8]; unpack8(k0w, v0); unpack8(r1w, v1); unpack8(r2w, v2); float ss = 0.f;
#pragma unroll
      for (int e = 0; e < 8; ++e) { v0[e] *= skv; ss += v0[e] * v0[e] + v1[e] * v1[e] + v2[e] * v2[e]; }
      ss += __shfl_xor(ss, 1); ss += __shfl_xor(ss, 2); ss += __shfl_xor(ss, 4);
      const float rinv = 1.f / sqrtf(ss * (1.f / 96.f) + EPS);
#pragma unroll
      for (int e = 0; e < 8; ++e) { v0[e] *= rinv * h0[e]; const float x1 = v1[e] * rinv * h1[e], x2 = v2[e] * rinv * h2[e]; v1[e] = x1 * cs[e] - x2 * sn[e]; v2[e] = x2 * cs[e] + x1 * sn[e]; }
      *(u32x4*)(KVr + head * 96 + sub * 8) = pack8(v0);
      if (rp) { *(u32x4*)(KVr + head * 96 + 64 + sub * 8) = pack8(v1); *(u32x4*)(KVr + head * 96 + 80 + sub * 8) = pack8(v2); } }
    { float v[8]; unpack8(vw, v);
#pragma unroll
      for (int e = 0; e < 8; ++e) v[e] *= skv;
      *vp = pack8(v); }
}

template <bool FULL, int DIR>
__device__ __forceinline__ void s5_dir(const Args& a, int l, int b, int g, int ch, int lane) {
    const bf16_t* PROJ = (const bf16_t*)(a.ws + WS_PROJ);
    const int ldg = (l * 2 + DIR) * NG + g, sidx = ldg * ST + lane;
    const f32x2 lam = ((const f32x2*)(a.ws + WS_LAMB))[sidx];
    float bre[16], bim[16];
    { const f32x4* bb = (const f32x4*)((const f32x2*)(a.ws + WS_BBAR) + (size_t)sidx * 16);
#pragma unroll
      for (int c2 = 0; c2 < 8; ++c2) { const f32x4 t = bb[c2]; bre[2 * c2] = t.x; bim[2 * c2] = t.y; bre[2 * c2 + 1] = t.z; bim[2 * c2 + 1] = t.w; } }
    float cre[16], cim[16];
    if (FULL) {
#pragma unroll
        for (int c = 0; c < 16; ++c) { cre[c] = a.in[16][((size_t)ldg * 16 + c) * ST + lane]; cim[c] = -a.in[17][((size_t)ldg * 16 + c) * ST + lane]; } }
    float sr = 0.f, si = 0.f;
    f32x2* E = (f32x2*)(a.ws + WS_E) + ((size_t)((b * NG + g) * 2 + DIR) * NCH) * ST + lane;
    if (FULL) {
        float pr = lam.x, pi = lam.y;
#pragma unroll
        for (int i = 0; i < 9; ++i) { const float t = pr * pr - pi * pi; pi = 2.f * pr * pi; pr = t; }
        if (DIR == 0) { for (int j = 0; j < ch; ++j) { const f32x2 e = E[(size_t)j * ST]; const float t = pr * sr - pi * si + e.x; si = pr * si + pi * sr + e.y; sr = t; } }
        else { for (int j = NCH - 1; j > ch; --j) { const f32x2 e = E[(size_t)j * ST]; const float t = pr * sr - pi * si + e.x; si = pr * si + pi * sr + e.y; sr = t; } }
    }
    const size_t row0 = (size_t)b * SEQ + (size_t)ch * CHUNK;
    for (int tile = 0; tile < CHUNK / 64; ++tile) {
        const int tt = (DIR == 0) ? tile : (CHUNK / 64 - 1 - tile);
        const size_t tok0 = row0 + (size_t)tt * 64;
        const u32x4* up = (const u32x4*)(PROJ + (tok0 + lane) * PROJ_N + 512 + g * 16);
        const u32x4 ua = up[0], ub = up[1];
        for (int t4 = 0; t4 < 16; ++t4) {
            float part[64];
#pragma unroll
            for (int q = 0; q < 4; ++q) {
                const int tl = t4 * 4 + q, tsel = (DIR == 0) ? tl : 63 - tl;
                unsigned w[8];
                w[0] = __builtin_amdgcn_readlane(ua.x, tsel); w[1] = __builtin_amdgcn_readlane(ua.y, tsel); w[2] = __builtin_amdgcn_readlane(ua.z, tsel); w[3] = __builtin_amdgcn_readlane(ua.w, tsel);
                w[4] = __builtin_amdgcn_readlane(ub.x, tsel); w[5] = __builtin_amdgcn_readlane(ub.y, tsel); w[6] = __builtin_amdgcn_readlane(ub.z, tsel); w[7] = __builtin_amdgcn_readlane(ub.w, tsel);
                float bur = 0.f, bui = 0.f;
#pragma unroll
                for (int c2 = 0; c2 < 8; ++c2) { const float u0 = bf_lo(w[c2]), u1 = bf_hi(w[c2]);
                    bur = fmaf(bre[2 * c2], u0, bur); bui = fmaf(bim[2 * c2], u0, bui); bur = fmaf(bre[2 * c2 + 1], u1, bur); bui = fmaf(bim[2 * c2 + 1], u1, bui); }
                const float nr = lam.x * sr - lam.y * si + bur, ni = lam.x * si + lam.y * sr + bui; sr = nr; si = ni;
                if (FULL) { constexpr int dummy = 0; (void)dummy; const int slot = (DIR == 0) ? q : 3 - q;
#pragma unroll
                    for (int c = 0; c < 16; ++c) part[slot * 16 + c] = cre[c] * sr + cim[c] * si; }
            }
            if (FULL) {
#define RSTEP(NK, XM) { const bool upb = (lane & XM) != 0; _Pragma("unroll") for (int i = 0; i < NK; ++i) { const float keep = upb ? part[i + NK] : part[i]; const float send = upb ? part[i] : part[i + NK]; part[i] = keep + __shfl_xor(send, XM); } }
                RSTEP(32, 32) RSTEP(16, 16) RSTEP(8, 8) RSTEP(4, 4) RSTEP(2, 2) RSTEP(1, 1)
#undef RSTEP
                const int tb = (DIR == 0) ? t4 * 4 : 60 - t4 * 4;
                const size_t row = tok0 + tb + (lane >> 4); const int c = lane & 15;
                float* yf = (float*)(a.ws + WS_YF) + row * 512 + g * 16 + c;
                if (DIR == 0) { *yf = part[0]; }
                else { const float u = bf2f(PROJ[row * PROJ_N + 512 + g * 16 + c]);
                    const float y = part[0] + *yf + a.in[18][l * 512 + g * 16 + c] * u;
                    const float z2 = 1.5957691216057308f * (y + 0.044715f * y * y * y);
                    const float ge = y * (1.f - __builtin_amdgcn_rcpf(1.f + __expf(z2)));
                    ((bf16_t*)(a.ws + WS_YG))[row * 512 + g * 16 + c] = f2bf(ge); }
            }
        }
    }
    if (!FULL) E[(size_t)ch * ST] = (f32x2){sr, si};
}
constexpr int S5_ROWB = 272, S5_LDS_WAVE = 32 * S5_ROWB;
template <bool FULL, int DIR>
__device__ __forceinline__ void s5m_dir(const Args& a, int l, int b, int g, int ch, int lane, LAS unsigned char* sl) {
    const bf16_t* PROJ = (const bf16_t*)(a.ws + WS_PROJ);
    const int ldg = (l * 2 + DIR) * NG + g, p1 = lane & 31, hi = lane >> 5;
    float lr[2], li[2], p4r[2], p4i[2];
#pragma unroll
    for (int s = 0; s < 2; ++s) { const f32x2 lm = ((const f32x2*)(a.ws + WS_LAMB))[ldg * ST + 32 * s + p1]; lr[s] = lm.x; li[s] = lm.y;
        const float q2r = lm.x * lm.x - lm.y * lm.y, q2i = 2.f * lm.x * lm.y; p4r[s] = q2r * q2r - q2i * q2i; p4i[s] = 2.f * q2r * q2i; }
    bf16x8 bfr[4];
#pragma unroll
    for (int j = 0; j < 4; ++j) { const f32x4* bb = (const f32x4*)((const f32x2*)(a.ws + WS_BBAR) + ((size_t)(ldg * ST + 32 * (j & 1) + p1)) * 16 + 8 * hi);
        const f32x4 t0 = bb[0], t1 = bb[1], t2 = bb[2], t3 = bb[3];
        u32x4 w;
        if ((j >> 1) == 0) { w.x = cvt_pk_bf16(t0.x, t0.z); w.y = cvt_pk_bf16(t1.x, t1.z); w.z = cvt_pk_bf16(t2.x, t2.z); w.w = cvt_pk_bf16(t3.x, t3.z); }
        else               { w.x = cvt_pk_bf16(t0.y, t0.w); w.y = cvt_pk_bf16(t1.y, t1.w); w.z = cvt_pk_bf16(t2.y, t2.w); w.w = cvt_pk_bf16(t3.y, t3.w); }
        bfr[j] = __builtin_bit_cast(bf16x8, w); }
    bf16x8 cfr[4];
    if (FULL) { const int c = lane & 15, kq = lane >> 4;
#pragma unroll
        for (int ks = 0; ks < 4; ++ks) { const int n0 = 32 * ks + 8 * kq;
            const float* cp = (ks < 2) ? (a.in[16] + ((size_t)ldg * 16 + c) * ST + n0) : (a.in[17] + ((size_t)ldg * 16 + c) * ST + (n0 - 64));
            const f32x4 t0 = ((const f32x4*)cp)[0], t1 = ((const f32x4*)cp)[1]; const float sg = (ks < 2) ? 1.f : -1.f;
            u32x4 w; w.x = cvt_pk_bf16(sg * t0.x, sg * t0.y); w.y = cvt_pk_bf16(sg * t0.z, sg * t0.w); w.z = cvt_pk_bf16(sg * t1.x, sg * t1.y); w.w = cvt_pk_bf16(sg * t1.z, sg * t1.w);
            cfr[ks] = __builtin_bit_cast(bf16x8, w); } }
    float cr[2] = {0.f, 0.f}, ci[2] = {0.f, 0.f};
    f32x2* E = (f32x2*)(a.ws + WS_E) + ((size_t)((b * NG + g) * 2 + DIR) * NCH) * ST;
    if (FULL) {
#pragma unroll
        for (int s = 0; s < 2; ++s) { float pr = lr[s], pi = li[s];
#pragma unroll
            for (int i = 0; i < 9; ++i) { const float t = pr * pr - pi * pi; pi = 2.f * pr * pi; pr = t; }
            if (DIR == 0) { for (int j = 0; j < ch; ++j) { const f32x2 e = E[(size_t)j * ST + 32 * s + p1]; const float t = pr * cr[s] - pi * ci[s] + e.x; ci[s] = pr * ci[s] + pi * cr[s] + e.y; cr[s] = t; } }
            else { for (int j = NCH - 1; j > ch; --j) { const f32x2 e = E[(size_t)j * ST + 32 * s + p1]; const float t = pr * cr[s] - pi * ci[s] + e.x; ci[s] = pr * ci[s] + pi * cr[s] + e.y; cr[s] = t; } } }
    }
    const size_t row0 = (size_t)b * SEQ + (size_t)ch * CHUNK;
    bf16x8 ua_next;
    { const size_t tk0 = row0 + (size_t)((DIR == 0) ? 0 : (CHUNK / 32 - 1)) * 32; const size_t tkA = (DIR == 0) ? tk0 + p1 : tk0 + 31 - p1;
      ua_next = *(const bf16x8*)(PROJ + tkA * PROJ_N + 512 + g * 16 + 8 * hi); }
    for (int tile = 0; tile < CHUNK / 32; ++tile) {
        const int tt = (DIR == 0) ? tile : (CHUNK / 32 - 1 - tile);
        const size_t tok0 = row0 + (size_t)tt * 32;
        const bf16x8 ua = ua_next;
        { const int tn = (tile + 1 < CHUNK / 32) ? tile + 1 : tile; const int ttn = (DIR == 0) ? tn : (CHUNK / 32 - 1 - tn);
          const size_t tk0 = row0 + (size_t)ttn * 32; const size_t tkA = (DIR == 0) ? tk0 + p1 : tk0 + 31 - p1;
          ua_next = *(const bf16x8*)(PROJ + tkA * PROJ_N + 512 + g * 16 + 8 * hi); }
        f32x16 acc[4];
#pragma unroll
        for (int j = 0; j < 4; ++j) { f32x16 z = {}; acc[j] = __builtin_amdgcn_mfma_f32_32x32x16_bf16(ua, bfr[j], z, 0, 0, 0); }
        float er[2][4], ei[2][4], eor[2][4], eoi[2][4];
#pragma unroll
        for (int s = 0; s < 2; ++s)
#pragma unroll
            for (int q = 0; q < 4; ++q) { float xr = acc[s][4 * q], xi = acc[2 + s][4 * q];
#pragma unroll
                for (int i = 1; i < 4; ++i) { const float t = lr[s] * xr - li[s] * xi + acc[s][4 * q + i]; xi = lr[s] * xi + li[s] * xr + acc[2 + s][4 * q + i]; xr = t; }
                { auto rr = __builtin_amdgcn_permlane32_swap(__float_as_uint(xr), __float_as_uint(xr), false, false); er[s][q] = __uint_as_float(rr[0]); eor[s][q] = __uint_as_float(rr[1]); }
                { auto ri = __builtin_amdgcn_permlane32_swap(__float_as_uint(xi), __float_as_uint(xi), false, false); ei[s][q] = __uint_as_float(ri[0]); eoi[s][q] = __uint_as_float(ri[1]); } }
        float cinr[2][4], cini[2][4];
#pragma unroll
        for (int s = 0; s < 2; ++s) { float c_r = cr[s], c_i = ci[s];
#pragma unroll
            for (int q = 0; q < 4; ++q) {
                const float c0r = c_r, c0i = c_i;
                { const float t = p4r[s] * c_r - p4i[s] * c_i + er[s][q]; c_i = p4r[s] * c_i + p4i[s] * c_r + ei[s][q]; c_r = t; }
                const float c1r = c_r, c1i = c_i;
                { const float t = p4r[s] * c_r - p4i[s] * c_i + eor[s][q]; c_i = p4r[s] * c_i + p4i[s] * c_r + eoi[s][q]; c_r = t; }
                cinr[s][q] = hi ? c1r : c0r; cini[s][q] = hi ? c1i : c0i; }
            cr[s] = c_r; ci[s] = c_i; }
        if (FULL) {
#pragma unroll
            for (int s = 0; s < 2; ++s)
#pragma unroll
                for (int q = 0; q < 4; ++q) { float xr = cinr[s][q], xi = cini[s][q];
#pragma unroll
                    for (int i = 0; i < 4; ++i) { const float t = lr[s] * xr - li[s] * xi + acc[s][4 * q + i]; xi = lr[s] * xi + li[s] * xr + acc[2 + s][4 * q + i]; xr = t;
                        acc[s][4 * q + i] = xr; acc[2 + s][4 * q + i] = xi; } }
#pragma unroll
            for (int j = 0; j < 4; ++j)
#pragma unroll
                for (int r = 0; r < 16; r += 2) { const unsigned w2 = cvt_pk_bf16(acc[j][r], acc[j][r + 1]);
                    const int rho = (r & 3) + 8 * (r >> 2) + 4 * hi; const int rw0 = (DIR == 0) ? rho : 31 - rho, rw1 = (DIR == 0) ? rho + 1 : 30 - rho;
                    *(LAS bf16_t*)(sl + rw0 * S5_ROWB + (32 * j + p1) * 2) = (bf16_t)(w2 & 0xffffu);
                    *(LAS bf16_t*)(sl + rw1 * S5_ROWB + (32 * j + p1) * 2) = (bf16_t)(w2 >> 16); }
#pragma unroll
            for (int mt = 0; mt < 2; ++mt) { f32x4 y = {0.f, 0.f, 0.f, 0.f};
#pragma unroll
                for (int ks = 0; ks < 4; ++ks) { const bf16x8 af = *(const LAS bf16x8*)(sl + (16 * mt + (lane & 15)) * S5_ROWB + (32 * ks + 8 * (lane >> 4)) * 2);
                    y = __builtin_amdgcn_mfma_f32_16x16x32_bf16(af, cfr[ks], y, 0, 0, 0); }
                const int c = lane & 15;
#pragma unroll
                for (int rg = 0; rg < 4; ++rg) { const size_t row = tok0 + 16 * mt + 4 * (lane >> 4) + rg;
                    float* yf = (float*)(a.ws + WS_YF) + row * 512 + g * 16 + c;
                    if (DIR == 0) { *yf = y[rg]; }
                    else { const float u = bf2f(PROJ[row * PROJ_N + 512 + g * 16 + c]);
                        const float yy = y[rg] + *yf + a.in[18][l * 512 + g * 16 + c] * u;
                        const float z2 = 1.5957691216057308f * (yy + 0.044715f * yy * yy * yy);
                        const float ge = yy * (1.f - __builtin_amdgcn_rcpf(1.f + __expf(z2)));
                        ((bf16_t*)(a.ws + WS_YG))[row * 512 + g * 16 + c] = f2bf(ge); } } }
        }
    }
    if (!FULL) { if (hi == 0) {
#pragma unroll
        for (int s = 0; s < 2; ++s) E[(size_t)ch * ST + 32 * s + p1] = (f32x2){cr[s], ci[s]}; } }
}
#ifndef S5_VALU
#define S5_VALU 0
#endif
template <bool FULL>
__device__ __forceinline__ void s5_item(const Args& a, int l, int item, int lane, LAS unsigned char* sl) {
    const int ch = item & (NCH - 1), g = (item >> 5) & 31, b = item >> 10;
#if S5_VALU
    s5_dir<FULL, 0>(a, l, b, g, ch, lane);
    s5_dir<FULL, 1>(a, l, b, g, ch, lane);
#else
    s5m_dir<FULL, 0>(a, l, b, g, ch, lane, sl);
    s5m_dir<FULL, 1>(a, l, b, g, ch, lane, sl);
#endif
}


#define XB_TMO      128
#define XB_XCNT(j)  (256  + 64 * (j))
#define XB_XSUB(j)  (1280 + 64 * (j))
#define XB_XGEN(j)  (2304 + 64 * (j))
#define XB_TOP      3328
#define XB_TOPGEN   3392
#define XCD_BAR_WORDS 3456
#define XB_SPIN_CAP (1u << 18)
__device__ __forceinline__ unsigned xb_ld(unsigned* p)              { return __hip_atomic_load(p, __ATOMIC_RELAXED, __HIP_MEMORY_SCOPE_AGENT); }
__device__ __forceinline__ unsigned xb_add(unsigned* p, unsigned v) { return __hip_atomic_fetch_add(p, v, __ATOMIC_RELAXED, __HIP_MEMORY_SCOPE_AGENT); }
__device__ __forceinline__ unsigned xb_xcc_id() { return (unsigned)__builtin_amdgcn_s_getreg((3 << 11) | 20) & 0xFu; }
#define XB_SPIN(cond, bar) do { unsigned _sp = 0; while (cond) { __builtin_amdgcn_s_sleep(1); \
    if ((++_sp & 255u) == 0u) { if (xb_ld(&(bar)[XB_TMO])) break; if (_sp > XB_SPIN_CAP) { atomicAdd(&(bar)[XB_TMO], 1u); break; } } } } while (0)
struct XcdBarrier { unsigned* bar; unsigned x; volatile LAS unsigned* st; };
__device__ __forceinline__ XcdBarrier xcd_barrier_post(unsigned* bar, volatile LAS unsigned* st) {
    XcdBarrier b; b.bar = bar; b.x = xb_xcc_id(); b.st = st;
    if (threadIdx.x == 0) (void)xb_add(&bar[XB_XCNT(b.x)], 1u);
    return b;
}
__device__ __forceinline__ void xcd_barrier_complete(unsigned* bar, unsigned x, unsigned& nloc, unsigned& nx) {
    const unsigned G = gridDim.x * gridDim.y * gridDim.z;
    unsigned sum, cnt, mine, sp = 0u;
    for (;;) {
        sum = 0u; cnt = 0u; mine = 0u;
#pragma unroll
        for (unsigned j = 0; j < 16; ++j) { const unsigned c = xb_ld(&bar[XB_XCNT(j)]); sum += c; cnt += (c > 0u) ? 1u : 0u; mine = (j == x) ? c : mine; }
        if (sum == G) break;
        __builtin_amdgcn_s_sleep(1);
        if ((++sp & 255u) == 0u) { if (xb_ld(&bar[XB_TMO])) break; if (sp > XB_SPIN_CAP) { atomicAdd(&bar[XB_TMO], 1u); break; } }
    }
    nloc = mine > 0u ? mine : 1u; nx = cnt > 0u ? cnt : 1u;
}
__device__ __forceinline__ void xcd_barrier(const XcdBarrier& b) {
    asm volatile("s_waitcnt vmcnt(0)" ::: "memory");
    __syncthreads();
    if (threadIdx.x == 0) {
        unsigned* bar = b.bar;
        __builtin_amdgcn_s_waitcnt(0);
        unsigned nloc = b.st[0], nx = b.st[1];
        if (nloc == 0u) { xcd_barrier_complete(bar, b.x, nloc, nx); b.st[0] = nloc; b.st[1] = nx; }
        const unsigned old = xb_add(&bar[XB_XSUB(b.x)], 1u);
        const unsigned gen = old / nloc;
        if (old + 1u == (gen + 1u) * nloc) {
            __builtin_amdgcn_fence(__ATOMIC_RELEASE, "agent");
            asm volatile("s_waitcnt vmcnt(0)" ::: "memory");
            const unsigned og = xb_add(&bar[XB_TOP], 1u);
            const unsigned tg = og / nx;
            if (og + 1u == (tg + 1u) * nx) xb_add(&bar[XB_TOPGEN], 1u);
            else XB_SPIN(xb_ld(&bar[XB_TOPGEN]) == tg, bar);
            __builtin_amdgcn_fence(__ATOMIC_ACQUIRE, "agent");
            xb_add(&bar[XB_XGEN(b.x)], 1u);
            asm volatile("s_waitcnt vmcnt(0)" ::: "memory");
        } else {
            XB_SPIN(xb_ld(&bar[XB_XGEN(b.x)]) == gen, bar);
            __builtin_amdgcn_fence(__ATOMIC_ACQUIRE, "agent");
            asm volatile("s_waitcnt vmcnt(0)" ::: "memory");
        }
    }
    __syncthreads();
}

constexpr int NPH_LAYER = 11, NPH = 1 + DEPTH * NPH_LAYER;
#ifndef PROBE_GEMM
#define PROBE_GEMM 0
#endif
template <class E_> __device__ __forceinline__ constexpr int gemm_rep_(const E_&) { return 1 + PROBE_GEMM; }
__device__ __forceinline__ constexpr int gemm_rep_(const pg8::EpiGateAcc&) { return 1; }
#define GEMM_REP(E) gemm_rep_(E)
#ifndef PROBE_ATT
#define PROBE_ATT 0
#endif
#ifndef PROBE_S5
#define PROBE_S5 0
#endif

template <int SP>
__device__ __forceinline__ void layer_phase(const Args& a, const int l, LAS unsigned char* ldsl, unsigned char* lds, const int G, const int bx, const int vcu, const int gw, const int NGW, const int lane_in) {
    int tid_ = threadIdx.x; asm volatile("" : "+v"(tid_));
    const int lane = tid_ & 63; (void)lane_in;
    unsigned char* ws = a.ws;
    const bf16_t* WL = (const bf16_t*)(ws + WS_W + (size_t)l * W_LAYER);
    const float* xin = (l == 0) ? a.in[0] : a.out;
    bf16_t* PROJ = (bf16_t*)(ws + WS_PROJ);
    if constexpr (SP == 0) {
        bf16_t* XN = (bf16_t*)(ws + WS_XN);
        for (int m = gw; m < M; m += 2 * NGW) { const int m2 = (m + NGW < M) ? m + NGW : m; norm_row2(xin + (size_t)m * DM, XN + (size_t)m * DM, xin + (size_t)m2 * DM, XN + (size_t)m2 * DM, lane); }
    } else if constexpr (SP == 1) {
        pg8::Gemm g{(const bf16_t*)(ws + WS_XN), (const bf16_t*)((const char*)WL + W0), M, PROJ_N, DM, DM};
        pg8::StaticOrder S; S.init(M, PROJ_N, G, bx);
        pg8::EpiBf E{PROJ, PROJ_N, 4};
        for (int rep_ = 0; rep_ < GEMM_REP(E); ++rep_) pg8::gemm_phase(ldsl, g, S, E);
    } else if constexpr (SP == 2) {
        { pg8::Gemm g{PROJ, (const bf16_t*)((const char*)WL + W1), M, 768, 256, PROJ_N};
          pg8::StaticOrder S; S.init(M, 768, G, bx);
          pg8::EpiBf E{(bf16_t*)(ws + WS_Q), LDQ, 1 << 30};
          for (int rep_ = 0; rep_ < GEMM_REP(E); ++rep_) pg8::gemm_phase(ldsl, g, S, E); }
        { pg8::Gemm g{PROJ + 256, (const bf16_t*)((const char*)WL + W2), M, 1280, 128, PROJ_N};
          pg8::StaticOrder S; S.init(M, 1280, G, (G % 16 == 0) ? (bx + G / 2) % G : bx);
          pg8::EpiBf E{(bf16_t*)(ws + WS_KV), LDKV, 1 << 30};
          for (int rep_ = 0; rep_ < GEMM_REP(E); ++rep_) pg8::gemm_phase(ldsl, g, S, E); }
        { int t2 = threadIdx.x; asm volatile("" : "+v"(t2)); const int lane2 = t2 & 63, wave2 = __builtin_amdgcn_readfirstlane(t2 >> 6);
        for (int rep = 0; rep < 1 + PROBE_S5; ++rep)
        for (int it = gw; it < BATCH * NG * NCH; it += NGW) s5_item<false>(a, l, it, lane2, ldsl + wave2 * S5_LDS_WAVE); }
    } else if constexpr (SP == 3) {
        for (int m = gw; m < M; m += NGW) postproc_row(a, l, m, lane);
    } else if constexpr (SP == 4) {
        bf16_t* Q = (bf16_t*)(ws + WS_Q); const bf16_t* KV = (const bf16_t*)(ws + WS_KV);
#if PROBE_ATT
        { bf16_t* DUM = (bf16_t*)(ws + WS_YF);
          for (int u = vcu; u < BATCH * NH * (SEQ / 256); u += G) {
            const int bh = u / (SEQ / 256), qb = u % (SEQ / 256), b = bh / NH, h = bh % NH;
            __syncthreads();
            bf16_t* Qb = Q + ((size_t)b * SEQ + (size_t)qb * 256) * LDQ + h * QKD;
            bf16_t* Ob = DUM + ((size_t)b * SEQ + (size_t)qb * 256) * LDQ + h * QKD;
            const bf16_t* Kh = KV + (size_t)b * SEQ * LDKV + h * QKD;
            const bf16_t* Vh = KV + (size_t)b * SEQ * LDKV + 768 + h * VD;
            att::attn_body(Qb, Kh, Vh, Ob, SEQ, (char*)lds);
          }
          cg::this_grid().sync(); }
#endif
        for (int u = vcu; u < BATCH * NH * (SEQ / 256); u += G) {
            const int bh = u / (SEQ / 256), qb = u % (SEQ / 256), b = bh / NH, h = bh % NH;
            __syncthreads();
            bf16_t* Qb = Q + ((size_t)b * SEQ + (size_t)qb * 256) * LDQ + h * QKD;
            const bf16_t* Kh = KV + (size_t)b * SEQ * LDKV + h * QKD;
            const bf16_t* Vh = KV + (size_t)b * SEQ * LDKV + 768 + h * VD;
            bf16_t* Ob = (bf16_t*)(ws + WS_ATT) + ((size_t)b * SEQ + (size_t)qb * 256) * 512 + h * VD;
            att::attn_pp(Qb, Kh, Vh, Ob, 512, SEQ, (char*)lds);
        }
        __syncthreads();
        { int t2 = threadIdx.x; asm volatile("" : "+v"(t2)); const int lane2 = t2 & 63, wave2 = __builtin_amdgcn_readfirstlane(t2 >> 6);
        for (int rep = 0; rep < 1 + PROBE_S5; ++rep)
        for (int it = gw; it < BATCH * NG * NCH; it += NGW) s5_item<true>(a, l, it, lane2, ldsl + wave2 * S5_LDS_WAVE); }
    } else if constexpr (SP == 5) {
        pg8::Gemm g{(const bf16_t*)(ws + WS_YG), (const bf16_t*)((const char*)WL + W4), M, 2048, 512, 512};
        pg8::StaticOrder S; S.init(M, 2048, G, bx);
        pg8::EpiPair<0> E{(bf16_t*)(ws + WS_MIX), DM, PROJ, PROJ_N, 2048};
        for (int rep_ = 0; rep_ < GEMM_REP(E); ++rep_) pg8::gemm_phase(ldsl, g, S, E);
    } else if constexpr (SP == 6) {
        pg8::Gemm g{(const bf16_t*)(ws + WS_ATT), (const bf16_t*)((const char*)WL + W3), M, 1024, 512, 512};
        pg8::StaticOrder S; S.init(M, 1024, G, bx);
        pg8::EpiGateAcc E{(bf16_t*)(ws + WS_MIX), DM, PROJ, PROJ_N, 1024};
        for (int rep_ = 0; rep_ < GEMM_REP(E); ++rep_) pg8::gemm_phase(ldsl, g, S, E);
    } else if constexpr (SP == 7) {
        pg8::Gemm g{(const bf16_t*)(ws + WS_MIX), (const bf16_t*)((const char*)WL + W5), M, 1024, 1024, DM};
        pg8::StaticOrder S; S.init(M, 1024, G, bx);
        pg8::EpiRes E{xin, (float*)(ws + WS_H)};
        for (int rep_ = 0; rep_ < GEMM_REP(E); ++rep_) pg8::gemm_phase(ldsl, g, S, E);
    } else if constexpr (SP == 8) {
        const float* H = (const float*)(ws + WS_H); bf16_t* HN = (bf16_t*)(ws + WS_HN);
        for (int m = gw; m < M; m += 2 * NGW) { const int m2 = (m + NGW < M) ? m + NGW : m; norm_row2(H + (size_t)m * DM, HN + (size_t)m * DM, H + (size_t)m2 * DM, HN + (size_t)m2 * DM, lane); }
    } else if constexpr (SP == 9) {
        pg8::Gemm g{(const bf16_t*)(ws + WS_HN), (const bf16_t*)((const char*)WL + W6), M, 2 * DFF, 1024, DM};
        pg8::StaticOrder S; S.init(M, 2 * DFF, G, bx);
        pg8::EpiPair<1> E{PROJ, DFF, nullptr, 0, 0};
        for (int rep_ = 0; rep_ < GEMM_REP(E); ++rep_) pg8::gemm_phase(ldsl, g, S, E);
    } else {
        pg8::Gemm g{PROJ, (const bf16_t*)((const char*)WL + W7), M, 1024, DFF, DFF};
        pg8::StaticOrder S; S.init(M, 1024, G, bx);
        pg8::EpiRes E{(const float*)(ws + WS_H), a.out};
        for (int rep_ = 0; rep_ < GEMM_REP(E); ++rep_) pg8::gemm_phase(ldsl, g, S, E);
    }
}


__global__ void __launch_bounds__(512) mega_fwd(Args a) {
    __builtin_assume(__builtin_amdgcn_workitem_id_y() == 0); __builtin_assume(__builtin_amdgcn_workitem_id_z() == 0);
    extern __shared__ __attribute__((aligned(16))) unsigned char lds[];
    cg::grid_group grid = cg::this_grid();
    const int tid = threadIdx.x, lane = tid & 63, wave = __builtin_amdgcn_readfirstlane(tid >> 6);
    const int G = gridDim.x, bx = blockIdx.x;
    const int vcu = (G % 8 == 0) ? (bx % 8) * (G / 8) + bx / 8 : bx;
    const int gw = vcu * 8 + wave, NGW = G * 8;
    LAS unsigned char* ldsl = (LAS unsigned char*)lds;
    unsigned char* ws = a.ws;


    const int lo = a.ph_lo, hi = a.ph_hi;
    unsigned* barw = (unsigned*)a.ws;
    volatile LAS unsigned* bst = (volatile LAS unsigned*)(ldsl + 131072);
    if (tid < 2) bst[tid] = 0u;
    if (bx == 0) { for (int i = tid; i < XCD_BAR_WORDS; i += 512) __hip_atomic_store(barw + i, 0u, __ATOMIC_RELAXED, __HIP_MEMORY_SCOPE_AGENT); }
    __syncthreads();
#define IN(k) (lo <= (k) && (k) < hi)
    if (IN(0)) p0_prologue(a, ldsl, gw, NGW, wave, lane);
    grid.sync();
    const XcdBarrier xbar = xcd_barrier_post(barw, bst);
#define SEAM(k) do { if ((k) + 1 < hi) xcd_barrier(xbar); } while (0)
#define LAYER(l) \
    if (IN(1 + (l) * NPH_LAYER + 0))  { layer_phase<0>(a, (l), ldsl, lds, G, bx, vcu, gw, NGW, lane);  SEAM(1 + (l) * NPH_LAYER + 0); } \
    if (IN(1 + (l) * NPH_LAYER + 1))  { layer_phase<1>(a, (l), ldsl, lds, G, bx, vcu, gw, NGW, lane);  SEAM(1 + (l) * NPH_LAYER + 1); } \
    if (IN(1 + (l) * NPH_LAYER + 2))  { layer_phase<2>(a, (l), ldsl, lds, G, bx, vcu, gw, NGW, lane);  SEAM(1 + (l) * NPH_LAYER + 2); } \
    if (IN(1 + (l) * NPH_LAYER + 3))  { layer_phase<3>(a, (l), ldsl, lds, G, bx, vcu, gw, NGW, lane);  SEAM(1 + (l) * NPH_LAYER + 3); } \
    if (IN(1 + (l) * NPH_LAYER + 4))  { layer_phase<4>(a, (l), ldsl, lds, G, bx, vcu, gw, NGW, lane);  SEAM(1 + (l) * NPH_LAYER + 4); } \
    if (IN(1 + (l) * NPH_LAYER + 5))  { layer_phase<5>(a, (l), ldsl, lds, G, bx, vcu, gw, NGW, lane);  SEAM(1 + (l) * NPH_LAYER + 5); } \
    if (IN(1 + (l) * NPH_LAYER + 6))  { layer_phase<6>(a, (l), ldsl, lds, G, bx, vcu, gw, NGW, lane);  SEAM(1 + (l) * NPH_LAYER + 6); } \
    if (IN(1 + (l) * NPH_LAYER + 7))  { layer_phase<7>(a, (l), ldsl, lds, G, bx, vcu, gw, NGW, lane);  SEAM(1 + (l) * NPH_LAYER + 7); } \
    if (IN(1 + (l) * NPH_LAYER + 8))  { layer_phase<8>(a, (l), ldsl, lds, G, bx, vcu, gw, NGW, lane);  SEAM(1 + (l) * NPH_LAYER + 8); } \
    if (IN(1 + (l) * NPH_LAYER + 9))  { layer_phase<9>(a, (l), ldsl, lds, G, bx, vcu, gw, NGW, lane);  SEAM(1 + (l) * NPH_LAYER + 9); } \
    if (IN(1 + (l) * NPH_LAYER + 10)) { layer_phase<10>(a, (l), ldsl, lds, G, bx, vcu, gw, NGW, lane); SEAM(1 + (l) * NPH_LAYER + 10); }
    LAYER(0)
    LAYER(1)
#undef LAYER
#undef IN
#undef SEAM
}

extern "C" void kernel_launch(void* const* d_in, const int* in_sizes, int n_in, void* d_out, int out_size, void* d_ws, size_t ws_size, hipStream_t stream) {
    static int grid = 0;
    if (grid == 0) {
        if (n_in != 25 || in_sizes[0] != M * DM || out_size != M * DM || ws_size < WS_END) {
            fprintf(stderr, "kernel_launch: shape/workspace mismatch (n_in %d, in0 %d, out %d, ws %zu, need %zu); nothing launched\n", n_in, n_in > 0 ? in_sizes[0] : -1, out_size, ws_size, (size_t)WS_END);
            grid = -1; return; }
        int dev = 0, cus = 0, per_cu = 0;
        if (hipGetDevice(&dev) != hipSuccess || hipDeviceGetAttribute(&cus, hipDeviceAttributeMultiprocessorCount, dev) != hipSuccess) { grid = -1; return; }
        if (hipFuncSetAttribute((const void*)mega_fwd, hipFuncAttributeMaxDynamicSharedMemorySize, LDS_BYTES) != hipSuccess) { fprintf(stderr, "kernel_launch: hipFuncSetAttribute failed\n"); grid = -1; return; }
        if (hipOccupancyMaxActiveBlocksPerMultiprocessor(&per_cu, (const void*)mega_fwd, 512, LDS_BYTES) != hipSuccess || per_cu < 1) {
            fprintf(stderr, "kernel_launch: occupancy query reports %d blocks per CU\n", per_cu); per_cu = 1; }
        (void)hipGetLastError();
        grid = cus;
    }
    if (grid < 0) return;
    Args a{};
    for (int i = 0; i < 25; ++i) a.in[i] = (const float*)d_in[i];
    a.out = (float*)d_out; a.ws = (unsigned char*)d_ws; a.ph_lo = 0; a.ph_hi = NPH;
    void* args[] = {&a};
    hipError_t e = hipLaunchCooperativeKernel((const void*)mega_fwd, dim3(grid), dim3(512), args, LDS_BYTES, stream);
    if (e != hipSuccess) fprintf(stderr, "kernel_launch: cooperative launch failed: %s (grid %d)\n", hipGetErrorString(e), grid);
}
```

```cpp
#include <hip/hip_runtime.h>
#include <hip/hip_cooperative_groups.h>
#include <cstdio>
#include <cstdint>
namespace cg = cooperative_groups;

#define LAS __attribute__((address_space(3)))
typedef unsigned short bf16_t;
typedef short bf16x8 __attribute__((ext_vector_type(8)));
typedef short s16x4 __attribute__((ext_vector_type(4)));
typedef float f32x4 __attribute__((ext_vector_type(4)));
typedef float f32x2 __attribute__((ext_vector_type(2)));
typedef float f32x16 __attribute__((ext_vector_type(16)));
typedef unsigned u32x4 __attribute__((ext_vector_type(4)));
typedef unsigned u32x2 __attribute__((ext_vector_type(2)));

constexpr int DM = 1024, BATCH = 2, SEQ = 16384, M = BATCH * SEQ, DEPTH = 2;
constexpr int NH = 8, QKD = 96, VD = 64;
constexpr int NG = 32, ST = 64;
constexpr int DFF = 2816;
constexpr int INC = 2976;
constexpr int PROJ_N = 3072;
constexpr int LDQ = 768, LDKV = 1280;
constexpr float EPS = 1e-6f;
constexpr int CHUNK = 512, NCH = SEQ / CHUNK;

constexpr size_t MiB = 1u << 20;
constexpr size_t WS_LAMB = 64 * 1024;
constexpr size_t WS_BBAR = 1 * MiB;
constexpr size_t WS_E = 2 * MiB;
constexpr size_t WS_W = 4 * MiB;
constexpr size_t W_LAYER = 30 * MiB;
constexpr size_t W0 = 0, W1 = 6291456, W2 = 6684672, W3 = 7012352, W4 = 8585216, W5 = 10682368, W6 = 12779520, W7 = 24313856;
constexpr size_t WS_PROJ = 64 * MiB;
constexpr size_t WS_Q = 256 * MiB;
constexpr size_t WS_KV = 304 * MiB;
constexpr size_t WS_XN = 256 * MiB;
constexpr size_t WS_H = 256 * MiB;
constexpr size_t WS_YF = 384 * MiB;
constexpr size_t WS_MIX = 384 * MiB;
constexpr size_t WS_HN = 384 * MiB;
constexpr size_t WS_YG = 448 * MiB;
constexpr size_t WS_ATT = 480 * MiB;
constexpr size_t WS_END = 512 * MiB;
constexpr int LDS_BYTES = 131072 + 256;

struct Args { const float* in[25]; float* out; unsigned char* ws; int ph_lo, ph_hi; };

__device__ __forceinline__ unsigned cvt_pk_bf16(float lo, float hi) { unsigned r; asm("v_cvt_pk_bf16_f32 %0, %1, %2" : "=v"(r) : "v"(lo), "v"(hi)); return r; }
__device__ __forceinline__ float bf_lo(unsigned w) { return __uint_as_float(w << 16); }
__device__ __forceinline__ float bf_hi(unsigned w) { return __uint_as_float(w & 0xffff0000u); }
__device__ __forceinline__ float bf2f(bf16_t h) { return __uint_as_float(((unsigned)h) << 16); }
__device__ __forceinline__ bf16_t f2bf(float f) { return (bf16_t)(cvt_pk_bf16(f, 0.f) & 0xffffu); }
__device__ __forceinline__ float sigm(float x) { return __builtin_amdgcn_rcpf(1.f + __expf(-x)); }
__device__ __forceinline__ float wave_sum(float v) {
#pragma unroll
    for (int o = 1; o < 64; o <<= 1) v += __shfl_xor(v, o);
    return v;
}

namespace pg8 {
constexpr int BM = 256, BK = 64, HALF = 128, HTB = HALF * BK * 2, NXCD = 8, WGM = 8;
__host__ __device__ __forceinline__ int lds_byte(int r, int c) { const int st = (r >> 4) * 2 + (c >> 5), rr = r & 15, cc = c & 31, ob = rr * 64 + cc * 2; return st * 1024 + (ob ^ (((ob >> 9) & 1) << 5)); }
__host__ __device__ __forceinline__ void stage_rc(int b, int& R, int& C) { const int st = b / 1024, sb = b % 1024, swz = sb ^ (((sb >> 9) & 1) << 5); R = (st >> 1) * 16 + swz / 64; C = (st & 1) * 32 + (swz % 64) / 2; }
__host__ __device__ __forceinline__ int perm32(int rho) { const int n = rho >> 4, i = rho & 15; return 8 * (i >> 2) + 4 * n + (i & 3); }

struct Unit { int pm, pn; };
struct Gemm { const bf16_t* A; const bf16_t* Bt; int M, N, K, lda; };

struct StaticOrder {
    int nM, nN, nwg, G, c;
    __device__ void init(int M_, int N_, int G_, int c_) { nM = M_ / BM; nN = N_ / BM; nwg = nM * nN; G = G_; c = c_; }
    __device__ bool next(int i, Unit& u) const {
        const long L = (long)i * G + c; if (L >= nwg) return false;
        int wgid = (int)L; { const int q = nwg / NXCD, r = nwg % NXCD, xcd = wgid % NXCD, off = wgid / NXCD; wgid = (xcd < r ? xcd * (q + 1) : r * (q + 1) + (xcd - r) * q) + off; }
        const int nig = WGM * nN, gid = wgid / nig, fm = gid * WGM, gsz = (nM - fm) < WGM ? (nM - fm) : WGM;
        u.pm = fm + ((wgid % nig) % gsz); u.pn = (wgid % nig) / gsz; return true;
    }
};

typedef f32x4 Acc[2][2][4][2];

struct EpiBf {
    static constexpr bool PERM = true;
    bf16_t* O; int ldc; int sig_from; int kvmap;
    __device__ __forceinline__ void operator()(const Acc& acc, const Unit& u, int wr, int wc, int fr, int fq) const {
        const int row0 = u.pm * BM + wr * 64 + fr, colg = u.pn * BM + wc * 32 + 8 * fq; const bool sg = u.pn >= sig_from;
        const int col0 = !kvmap ? colg : (colg < 512 ? (colg >> 6) * 96 + (colg & 63) : colg + 256);
        const int bjs = !kvmap ? HALF : (colg < 512 ? 192 : HALF);
#pragma unroll
        for (int ai = 0; ai < 2; ++ai)
#pragma unroll
            for (int m = 0; m < 4; ++m) { bf16_t* rowp = O + (size_t)(row0 + ai * HALF + m * 16) * ldc + col0;
#pragma unroll
                for (int bj = 0; bj < 2; ++bj) { f32x4 v0 = acc[ai][bj][m][0], v1 = acc[ai][bj][m][1];
                    if (sg) {
#pragma unroll
                        for (int i = 0; i < 4; ++i) { v0[i] = sigm(v0[i]); v1[i] = sigm(v1[i]); } }
                    u32x4 w; w.x = cvt_pk_bf16(v0[0], v0[1]); w.y = cvt_pk_bf16(v0[2], v0[3]); w.z = cvt_pk_bf16(v1[0], v1[1]); w.w = cvt_pk_bf16(v1[2], v1[3]);
                    *(u32x4*)(rowp + bj * bjs) = w; }
                asm volatile("" ::: "memory"); }
    }
};
template <int MODE> struct EpiPair {
    static constexpr bool PERM = true;
    bf16_t* O; int ldc; const bf16_t* gate; int ldg, goff;
    __device__ __forceinline__ void operator()(const Acc& acc, const Unit& u, int wr, int wc, int fr, int fq) const {
        const int row0 = u.pm * BM + wr * 64 + fr, j00 = u.pn * 128 + wc * 16 + 4 * fq;
#pragma unroll
        for (int ai = 0; ai < 2; ++ai)
#pragma unroll
            for (int m = 0; m < 4; ++m) { const size_t row = (size_t)(row0 + ai * HALF + m * 16);
#pragma unroll
                for (int bj = 0; bj < 2; ++bj) { const int j0 = j00 + bj * 64; const f32x4 a = acc[ai][bj][m][0], b = acc[ai][bj][m][1]; float o[4];
                    if (MODE == 0) { const u32x2 gw = *(const u32x2*)(gate + row * ldg + goff + j0);
                        const float g0 = bf_lo(gw.x), g1 = bf_hi(gw.x), g2 = bf_lo(gw.y), g3 = bf_hi(gw.y);
                        o[0] = g0 * a[0] * sigm(b[0]); o[1] = g1 * a[1] * sigm(b[1]); o[2] = g2 * a[2] * sigm(b[2]); o[3] = g3 * a[3] * sigm(b[3]);
                    } else {
#pragma unroll
                        for (int i = 0; i < 4; ++i) o[i] = a[i] * sigm(a[i]) * b[i]; }
                    u32x2 w; w.x = cvt_pk_bf16(o[0], o[1]); w.y = cvt_pk_bf16(o[2], o[3]);
                    *(u32x2*)(O + row * ldc + j0) = w; }
                asm volatile("" ::: "memory"); }
    }
};
struct EpiGateAcc {
    static constexpr bool PERM = true;
    bf16_t* O; int ldc; const bf16_t* gate; int ldg, goff;
    __device__ __forceinline__ void operator()(const Acc& acc, const Unit& u, int wr, int wc, int fr, int fq) const {
        const int row0 = u.pm * BM + wr * 64 + fr, col0 = u.pn * BM + wc * 32 + 8 * fq;
#pragma unroll
        for (int ai = 0; ai < 2; ++ai)
#pragma unroll
            for (int m = 0; m < 4; ++m) { const size_t row = (size_t)(row0 + ai * HALF + m * 16);
#pragma unroll
                for (int bj = 0; bj < 2; ++bj) { const int col = col0 + bj * HALF; const f32x4 v0 = acc[ai][bj][m][0], v1 = acc[ai][bj][m][1];
                    const u32x4 gw = *(const u32x4*)(gate + row * ldg + goff + col); const u32x4 mw = *(const u32x4*)(O + row * ldc + col);
                    u32x4 w;
                    w.x = cvt_pk_bf16(bf_lo(gw.x) * v0[0] + bf_lo(mw.x), bf_hi(gw.x) * v0[1] + bf_hi(mw.x));
                    w.y = cvt_pk_bf16(bf_lo(gw.y) * v0[2] + bf_lo(mw.y), bf_hi(gw.y) * v0[3] + bf_hi(mw.y));
                    w.z = cvt_pk_bf16(bf_lo(gw.z) * v1[0] + bf_lo(mw.z), bf_hi(gw.z) * v1[1] + bf_hi(mw.z));
                    w.w = cvt_pk_bf16(bf_lo(gw.w) * v1[2] + bf_lo(mw.w), bf_hi(gw.w) * v1[3] + bf_hi(mw.w));
                    *(u32x4*)(O + row * ldc + col) = w; }
                asm volatile("" ::: "memory"); }
    }
};
struct EpiRes {
    static constexpr bool PERM = false;
    const float* base; float* out;
    __device__ __forceinline__ void operator()(const Acc& acc, const Unit& u, int wr, int wc, int fr, int fq) const {
        const int row0 = u.pm * BM + wr * 64 + fr, col0 = u.pn * BM + wc * 32 + 4 * fq;
#pragma unroll
        for (int ai = 0; ai < 2; ++ai)
#pragma unroll
            for (int m = 0; m < 4; ++m) { const size_t off = (size_t)(row0 + ai * HALF + m * 16) * DM + col0;
#pragma unroll
                for (int bj = 0; bj < 2; ++bj)
#pragma unroll
                    for (int n = 0; n < 2; ++n) { const f32x4 bs = *(const f32x4*)(base + off + bj * HALF + n * 16);
                        *(f32x4*)(out + off + bj * HALF + n * 16) = bs + acc[ai][bj][m][n]; }
                asm volatile("" ::: "memory"); }
    }
};

template <class Epi>
__device__ __forceinline__ void gemm_phase(LAS unsigned char* lds, const Gemm g, const StaticOrder& S, const Epi& E) {
    int tid = threadIdx.x; asm volatile("" : "+v"(tid));
    const int wid = __builtin_amdgcn_readfirstlane(tid >> 6), lane = tid & 63, wr = wid >> 2, wc = wid & 3, fr = lane & 15, fq = lane >> 4;
    const int K = g.K, nt = K / BK, lda = g.lda;
    unsigned voffA[2], voffB[2];
#pragma unroll
    for (int i = 0; i < 2; ++i) { int R, C; stage_rc(tid * 16 + i * 8192, R, C); const int Rb = Epi::PERM ? ((R & ~31) + perm32(R & 31)) : R;
        voffA[i] = (unsigned)(R * lda + C) * 2u; voffB[i] = (unsigned)(Rb * K + C) * 2u; }
    const size_t kstep = (size_t)(BK * 2);
    const size_t hA = (size_t)HALF * lda * 2, hB = (size_t)HALF * K * 2;
    const size_t tA = 2 * hA, tB = 2 * hB;
    const unsigned ldsw = (unsigned)wid * 1024u;
    const int aoff = lds_byte(wr * 64 + fr, fq * 8), boff = lds_byte(wc * 32 + fr, fq * 8);
#define PG8_SA(b, h) (((b) * 2 + (h)) * HTB)
#define PG8_SB(b, h) ((4 + (b) * 2 + (h)) * HTB)
#define PG8_STAGE(bufoff, gbase, voff) do { _Pragma("unroll") for (int _i = 0; _i < 2; ++_i) \
        __builtin_amdgcn_global_load_lds((const unsigned*)((const char*)(gbase) + (voff)[_i]), (LAS unsigned*)(lds + (bufoff) + ldsw + _i * 8192), 16, 0, 0); } while (0)
#define PG8_LDA(dst, b, h) do { _Pragma("unroll") for (int m = 0; m < 4; ++m) _Pragma("unroll") for (int k = 0; k < 2; ++k) dst[m][k] = *(const LAS bf16x8*)(lds + PG8_SA(b, h) + aoff + m * 2048 + k * 1024); } while (0)
#define PG8_LDB(dst, b, h) do { _Pragma("unroll") for (int n = 0; n < 2; ++n) _Pragma("unroll") for (int k = 0; k < 2; ++k) dst[n][k] = *(const LAS bf16x8*)(lds + PG8_SB(b, h) + boff + n * 2048 + k * 1024); } while (0)
#define PG8_MMA(ai, bj, At, Bt) do { __builtin_amdgcn_s_setprio(1); _Pragma("unroll") for (int m = 0; m < 4; ++m) _Pragma("unroll") for (int n = 0; n < 2; ++n) _Pragma("unroll") for (int k = 0; k < 2; ++k) \
        acc[ai][bj][m][n] = __builtin_amdgcn_mfma_f32_16x16x32_bf16(Bt[n][k], At[m][k], acc[ai][bj][m][n], 0, 0, 0); __builtin_amdgcn_s_setprio(0); } while (0)
#define PG8_WAIT_V(n) asm volatile("s_waitcnt vmcnt(" #n ")" ::: "memory")
#define PG8_WAIT_L(n) asm volatile("s_waitcnt lgkmcnt(" #n ")" ::: "memory")
#define PG8_BAR __builtin_amdgcn_s_barrier()
#define PG8_SCHED __builtin_amdgcn_sched_barrier(0)
    Unit cur, nxt; int ui = 0;
    if (!S.next(0, cur)) return;
    Acc acc;
#pragma unroll
    for (int a = 0; a < 2; ++a)
#pragma unroll
        for (int b = 0; b < 2; ++b)
#pragma unroll
            for (int m = 0; m < 4; ++m)
#pragma unroll
                for (int n = 0; n < 2; ++n) acc[a][b][m][n] = (f32x4){0.f, 0.f, 0.f, 0.f};
    bf16x8 At[4][2], B0[2][2], B1[2][2];
    const char* cA = (const char*)g.A + (size_t)cur.pm * tA; const char* cB = (const char*)g.Bt + (size_t)cur.pn * tB;
    PG8_STAGE(PG8_SB(0, 0), cB, voffB); PG8_STAGE(PG8_SB(0, 1), cB + hB, voffB); PG8_STAGE(PG8_SA(0, 0), cA, voffA); PG8_STAGE(PG8_SA(0, 1), cA + hA, voffA);
    if (wr == 1) PG8_BAR;
    PG8_WAIT_V(2); PG8_BAR;
    PG8_STAGE(PG8_SB(1, 0), cB + kstep, voffB); PG8_STAGE(PG8_SA(1, 0), cA + kstep, voffA); PG8_STAGE(PG8_SB(1, 1), cB + hB + kstep, voffB);
    PG8_WAIT_V(6); PG8_BAR;
    for (;;) {
        const bool has_next = S.next(ui + 1, nxt);
        const char* nA = has_next ? (const char*)g.A + (size_t)nxt.pm * tA : cA; const char* nB = has_next ? (const char*)g.Bt + (size_t)nxt.pn * tB : cB;
        for (int t = 0; t < nt; t += 2) {
            const bool last = (t == nt - 2);
            const char* a1 = cA + (size_t)(t + 1) * kstep;
            const char* a2 = last ? nA : cA + (size_t)(t + 2) * kstep; const char* b2 = last ? nB : cB + (size_t)(t + 2) * kstep;
            const char* a3 = a2 + kstep; const char* b3 = b2 + kstep;
            PG8_LDB(B0, 0, 0); PG8_LDB(B1, 0, 1); PG8_SCHED; PG8_LDA(At, 0, 0); PG8_STAGE(PG8_SA(1, 1), a1 + hA, voffA);
            PG8_WAIT_V(8); PG8_WAIT_L(0); PG8_BAR; PG8_MMA(0, 0, At, B0); PG8_MMA(0, 1, At, B1); PG8_BAR; PG8_SCHED;
            PG8_LDA(At, 0, 1); PG8_STAGE(PG8_SB(0, 0), b2, voffB); PG8_STAGE(PG8_SB(0, 1), b2 + hB, voffB); PG8_STAGE(PG8_SA(0, 0), a2, voffA);
            PG8_WAIT_V(8); PG8_WAIT_L(0); PG8_BAR; PG8_MMA(1, 0, At, B0); PG8_MMA(1, 1, At, B1); PG8_BAR; PG8_SCHED;
            PG8_LDB(B0, 1, 0); PG8_LDB(B1, 1, 1); PG8_SCHED; PG8_LDA(At, 1, 0); PG8_STAGE(PG8_SA(0, 1), a2 + hA, voffA);
            PG8_WAIT_V(8); PG8_WAIT_L(0); PG8_BAR; PG8_MMA(0, 0, At, B0); PG8_MMA(0, 1, At, B1); PG8_BAR; PG8_SCHED;
            PG8_LDA(At, 1, 1); PG8_STAGE(PG8_SB(1, 0), b3, voffB); PG8_STAGE(PG8_SB(1, 1), b3 + hB, voffB); PG8_STAGE(PG8_SA(1, 0), a3, voffA);
            PG8_WAIT_V(8); PG8_WAIT_L(0); PG8_BAR; PG8_MMA(1, 0, At, B0); PG8_MMA(1, 1, At, B1); PG8_BAR; PG8_SCHED;
        }
        if (wr == 0) PG8_BAR;
        E(acc, cur, wr, wc, fr, fq);
        if (!has_next) break;
#pragma unroll
        for (int a = 0; a < 2; ++a)
#pragma unroll
            for (int b = 0; b < 2; ++b)
#pragma unroll
                for (int m = 0; m < 4; ++m)
#pragma unroll
                    for (int n = 0; n < 2; ++n) acc[a][b][m][n] = (f32x4){0.f, 0.f, 0.f, 0.f};
        cur = nxt; cA = nA; cB = nB; ++ui;
        if (wr == 1) PG8_BAR;
    }
    PG8_WAIT_V(0);
    PG8_BAR;
#undef PG8_SA
#undef PG8_SB
#undef PG8_STAGE
#undef PG8_LDA
#undef PG8_LDB
#undef PG8_MMA
#undef PG8_WAIT_V
#undef PG8_WAIT_L
#undef PG8_BAR
#undef PG8_SCHED
}
}

namespace att {
constexpr int NW = 8, QBLK = 32, KVBLK = 64;
constexpr float SCALE = 0.10206207261596575f;
constexpr float THR = 8.f;
constexpr size_t SHM_V = KVBLK * 128 * 2, SHM_K = KVBLK * 128 * 2;
#define KSWZ(row, colB) ((row) * 256 + ((colB) ^ (((row) & 15) << 4)))
#define SBAR() __builtin_amdgcn_sched_barrier(0)
__device__ __forceinline__ int crow(int r, int hi) { return (r & 3) + 8 * (r >> 2) + 4 * hi; }
__device__ __forceinline__ unsigned cvtpk(float lo, float hi) { unsigned r; asm volatile("v_cvt_pk_bf16_f32 %0, %1, %2" : "=v"(r) : "v"(lo), "v"(hi)); return r; }

constexpr float THRL = THR * 1.4426950408889634f;
__device__ __forceinline__ void partialSM(f32x16& p0, f32x16& p1, float& mhat, f32x16& negm, float& alpha) {
    float pmax = p0[0];
#pragma unroll
    for (int r = 1; r < 16; ++r) pmax = fmaxf(pmax, p0[r]);
#pragma unroll
    for (int r = 0; r < 16; ++r) pmax = fmaxf(pmax, p1[r]);
    { auto rr = __builtin_amdgcn_permlane32_swap(__float_as_uint(pmax), __float_as_uint(pmax), false, false);
      pmax = fmaxf(__uint_as_float(rr[0]), __uint_as_float(rr[1])); }
    if (__builtin_expect(__all(pmax <= THRL), 1)) { alpha = 1.f; }
    else { const float dl = fmaxf(pmax, 0.f); mhat += dl;
#pragma unroll
        for (int r = 0; r < 16; ++r) { p0[r] -= dl; p1[r] -= dl; }
#pragma unroll
        for (int r = 0; r < 16; ++r) negm[r] = -mhat;
        alpha = __builtin_amdgcn_exp2f(-dl); }
    asm volatile("" : "+v"(negm));
#pragma unroll
    for (int r = 0; r < 16; ++r) p0[r] = __builtin_amdgcn_exp2f(p0[r]);
}
__device__ __forceinline__ void finishSM(f32x16& p0, f32x16& p1, float alpha, float& l_reg, bf16x8& pa0, bf16x8& pa1, bf16x8& pa2, bf16x8& pa3) {
#pragma unroll
    for (int r = 0; r < 16; ++r) p1[r] = __builtin_amdgcn_exp2f(p1[r]);
    float ps, psa = 0, psb = 0, psc = 0, psd = 0;
#pragma unroll
    for (int r = 0; r < 16; r += 4) { psa += p0[r]; psb += p0[r + 1]; psc += p0[r + 2]; psd += p0[r + 3]; }
#pragma unroll
    for (int r = 0; r < 16; r += 4) { psa += p1[r]; psb += p1[r + 1]; psc += p1[r + 2]; psd += p1[r + 3]; }
    ps = (psa + psb) + (psc + psd);
    { auto rr = __builtin_amdgcn_permlane32_swap(__float_as_uint(ps), __float_as_uint(ps), false, false);
      ps = __uint_as_float(rr[0]) + __uint_as_float(rr[1]); }
    l_reg = l_reg * alpha + ps;
#define PK4(P, BASE, OUT) do { unsigned a0 = cvtpk(P[BASE + 0], P[BASE + 1]), a1 = cvtpk(P[BASE + 2], P[BASE + 3]);   \
    unsigned b0 = cvtpk(P[BASE + 4], P[BASE + 5]), b1 = cvtpk(P[BASE + 6], P[BASE + 7]);                              \
    auto r0 = __builtin_amdgcn_permlane32_swap(a0, b0, false, false); auto r1 = __builtin_amdgcn_permlane32_swap(a1, b1, false, false); \
    u32x4 w = {r0[0], r1[0], r0[1], r1[1]}; OUT = *reinterpret_cast<bf16x8*>(&w); } while (0)
    PK4(p0, 0, pa0); PK4(p0, 8, pa1); PK4(p1, 0, pa2); PK4(p1, 8, pa3);
#undef PK4
}
__device__ __forceinline__ void qkt(f32x16& p0, f32x16& p1, const char* Ks, const bf16x8* qr, const f32x16& negm, int r32, int hi) {
#pragma unroll
    for (int d0 = 0; d0 < 6; ++d0) { int cb = (d0 * 16 + hi * 8) * 2;
        bf16x8 b0 = *reinterpret_cast<const bf16x8*>(Ks + KSWZ(r32, cb));
        bf16x8 b1 = *reinterpret_cast<const bf16x8*>(Ks + KSWZ(32 + r32, cb));
        if (d0 == 0) { p0 = __builtin_amdgcn_mfma_f32_32x32x16_bf16(b0, qr[0], negm, 0, 0, 0); p1 = __builtin_amdgcn_mfma_f32_32x32x16_bf16(b1, qr[0], negm, 0, 0, 0); }
        else { p0 = __builtin_amdgcn_mfma_f32_32x32x16_bf16(b0, qr[d0], p0, 0, 0, 0); p1 = __builtin_amdgcn_mfma_f32_32x32x16_bf16(b1, qr[d0], p1, 0, 0, 0); } }
}
__device__ __forceinline__ int v_st(int k, int c) { const int kk = (k & ~0xC) | ((k & 4) << 1) | ((k & 8) >> 1); return ((kk >> 3) * 4 + (c >> 5)) * 512 + ((kk & 7) * 32 + (c & 31)) * 2; }
__device__ __forceinline__ int v_rd_base(int lane) { return ((lane & 3) << 3) | (((lane >> 2) & 3) << 6) | (((lane >> 4) & 1) << 5) | (((lane >> 5) & 1) << 8); }
constexpr int v_rd_off(int d0, int ks, int half) { return d0 * 512 + ks * 4096 + half * 2048; }
template <int OFF> __device__ __forceinline__ s16x4 tr_read(int vb) {
    s16x4 r; asm volatile("ds_read_b64_tr_b16 %0, %1 offset:%2" : "=&v"(r) : "v"(vb), "i"(OFF) : "memory"); return r;
}
template <int D0> __device__ __forceinline__ void pv_one(f32x16& od, int vb, bf16x8 pa0, bf16x8 pa1, bf16x8 pa2, bf16x8 pa3) {
    const s16x4 l0 = tr_read<v_rd_off(D0, 0, 0)>(vb), h0 = tr_read<v_rd_off(D0, 0, 1)>(vb), l1 = tr_read<v_rd_off(D0, 1, 0)>(vb), h1 = tr_read<v_rd_off(D0, 1, 1)>(vb);
    const s16x4 l2 = tr_read<v_rd_off(D0, 2, 0)>(vb), h2 = tr_read<v_rd_off(D0, 2, 1)>(vb), l3 = tr_read<v_rd_off(D0, 3, 0)>(vb), h3 = tr_read<v_rd_off(D0, 3, 1)>(vb);
    asm volatile("s_waitcnt lgkmcnt(0)" ::: "memory"); SBAR();
#define PK(L, H) (bf16x8){L[0], L[1], L[2], L[3], H[0], H[1], H[2], H[3]}
    od = __builtin_amdgcn_mfma_f32_32x32x16_bf16(pa0, PK(l0, h0), od, 0, 0, 0);
    od = __builtin_amdgcn_mfma_f32_32x32x16_bf16(pa1, PK(l1, h1), od, 0, 0, 0);
    od = __builtin_amdgcn_mfma_f32_32x32x16_bf16(pa2, PK(l2, h2), od, 0, 0, 0);
    od = __builtin_amdgcn_mfma_f32_32x32x16_bf16(pa3, PK(l3, h3), od, 0, 0, 0);
#undef PK
}
__device__ __forceinline__ void pv_d0(f32x16* o, int vb, bf16x8 pa0, bf16x8 pa1, bf16x8 pa2, bf16x8 pa3) {
    pv_one<0>(o[0], vb, pa0, pa1, pa2, pa3); pv_one<1>(o[1], vb, pa0, pa1, pa2, pa3);
}

__device__ __forceinline__ void attn_body(const bf16_t* Qb, const bf16_t* __restrict__ Kh, const bf16_t* __restrict__ Vh, bf16_t* Ob, int seq, char* lds) {
    int tid = threadIdx.x; asm volatile("" : "+v"(tid));
    const int wid = tid >> 6, lane = tid & 63, r32 = lane & 31, hi = lane >> 5;
    char* V_lds = lds; char* K_lds = lds + 2 * SHM_V;
    float* ws = (float*)(lds + 2 * SHM_V + 2 * SHM_K) + wid * 64; float* li_l = ws; float* al_l = ws + 32;
    float mhat = 0.f, l_reg = 0; f32x16 o[2] = {}; bf16x8 qr[6]; f32x16 negm = f32x16{}; asm volatile("" : "+v"(negm));
    const bf16_t* Qw = Qb + (long)(wid * QBLK + r32) * LDQ + hi * 8;
#pragma unroll
    for (int d0 = 0; d0 < 6; ++d0) qr[d0] = *reinterpret_cast<const bf16x8*>(Qw + d0 * 16);
    const int kc0 = tid, kc1 = (tid < 256) ? 512 + tid : tid;
    const int kr0 = kc0 / 12, kcc0 = kc0 % 12, kr1 = kc1 / 12, kcc1 = kc1 % 12;
    const bool k1ok = tid < 256;
    const int vr = tid >> 3, vc = (tid & 7) * 8;
    const int kst0 = KSWZ(kr0, kcc0 * 16), kst1 = KSWZ(kr1, kcc1 * 16), vst = v_st(vr, vc);
    const int vb0 = (int)(uintptr_t)V_lds + v_rd_base(lane);
    struct { bf16x8 v, k0, k1; } sr_[2];
#define SLOAD(i, kk0) do { sr_[i].v = *reinterpret_cast<const bf16x8*>(&Vh[(long)((kk0) + vr) * LDKV + vc]); \
    sr_[i].k0 = *reinterpret_cast<const bf16x8*>(&Kh[(long)((kk0) + kr0) * LDKV + kcc0 * 8]); \
    sr_[i].k1 = *reinterpret_cast<const bf16x8*>(&Kh[(long)((kk0) + kr1) * LDKV + kcc1 * 8]); } while (0)
#define SWRITE(b, i) do { *(bf16x8*)(V_lds + (b) * SHM_V + vst) = sr_[i].v; \
    *(bf16x8*)(K_lds + (b) * SHM_K + kst0) = sr_[i].k0; \
    if (k1ok) *(bf16x8*)(K_lds + (b) * SHM_K + kst1) = sr_[i].k1; } while (0)
#define SWAIT() asm volatile("s_waitcnt vmcnt(3)" ::: "memory")
#define RESC(a) do { if (__any((a) < 1.f)) { if (hi == 0) al_l[r32] = (a); asm volatile("s_waitcnt lgkmcnt(0)" ::: "memory"); \
    _Pragma("unroll") for (int d = 0; d < 2; ++d) _Pragma("unroll") for (int r = 0; r < 16; ++r) o[d][r] *= al_l[crow(r, hi)]; } } while (0)
    f32x16 pA0, pA1, pB0, pB1; float alA, alB; bf16x8 pa0, pa1, pa2, pa3; const int NT = seq / KVBLK;
    constexpr int SE = 0, SO = 1;
    SLOAD(SE, 0); asm volatile("s_waitcnt vmcnt(0)" ::: "memory"); SWRITE(0, SE); __syncthreads();
    qkt(pA0, pA1, K_lds, qr, negm, r32, hi); partialSM(pA0, pA1, mhat, negm, alA);
    SLOAD(SO, KVBLK); SLOAD(SE, 2 * KVBLK);
    SWAIT(); SWRITE(1, SO); __syncthreads();
    for (int j = 1; j + 1 < NT; j += 2) {
        SBAR(); qkt(pB0, pB1, K_lds + SHM_K, qr, negm, r32, hi);
        finishSM(pA0, pA1, alA, l_reg, pa0, pa1, pa2, pa3); SBAR();
        SLOAD(SO, (j + 2) * KVBLK); SBAR();
        pv_d0(o, vb0, pa0, pa1, pa2, pa3); partialSM(pB0, pB1, mhat, negm, alB);
        __syncthreads(); SWAIT(); SWRITE(0, SE);
        RESC(alB); __syncthreads();
        SBAR(); qkt(pA0, pA1, K_lds, qr, negm, r32, hi);
        finishSM(pB0, pB1, alB, l_reg, pa0, pa1, pa2, pa3); SBAR();
        { const int jn = (j + 3 < NT) ? (j + 3) : (NT - 1); SLOAD(SE, jn * KVBLK); } SBAR();
        pv_d0(o, vb0 + (int)SHM_V, pa0, pa1, pa2, pa3); partialSM(pA0, pA1, mhat, negm, alA);
        __syncthreads(); SWAIT(); SWRITE(1, SO);
        RESC(alA); __syncthreads();
    }
    SBAR(); qkt(pB0, pB1, K_lds + SHM_K, qr, negm, r32, hi);
    finishSM(pA0, pA1, alA, l_reg, pa0, pa1, pa2, pa3); SBAR();
    pv_d0(o, vb0, pa0, pa1, pa2, pa3); partialSM(pB0, pB1, mhat, negm, alB);
    __syncthreads(); RESC(alB);
    finishSM(pB0, pB1, alB, l_reg, pa0, pa1, pa2, pa3); SBAR();
    pv_d0(o, vb0 + (int)SHM_V, pa0, pa1, pa2, pa3);
    if (hi == 0) li_l[r32] = l_reg; asm volatile("s_waitcnt lgkmcnt(0)" ::: "memory");
    float rli[16];
#pragma unroll
    for (int r = 0; r < 16; ++r) rli[r] = __builtin_amdgcn_rcpf(li_l[crow(r, hi)]);
    bf16_t* Ow = Ob + (long)(wid * QBLK) * LDQ;
#pragma unroll
    for (int r = 0; r < 16; ++r) { int orow = crow(r, hi);
#pragma unroll
        for (int d0 = 0; d0 < 2; ++d0) Ow[(long)orow * LDQ + d0 * 32 + r32] = f2bf(o[d0][r] * rli[r]); }
#undef SLOAD
#undef SWRITE
#undef SWAIT
#undef RESC
}

__device__ __forceinline__ bool partialSM_abs(f32x16& p0, f32x16& p1, float& mhat, float& alpha) {
    float pmax = p0[0], pmb = p1[0];
#pragma unroll
    for (int r = 1; r < 16; ++r) { pmax = fmaxf(pmax, p0[r]); pmb = fmaxf(pmb, p1[r]); }
    pmax = fmaxf(pmax, pmb);
    { auto rr = __builtin_amdgcn_permlane32_swap(__float_as_uint(pmax), __float_as_uint(pmax), false, false);
      pmax = fmaxf(__uint_as_float(rr[0]), __uint_as_float(rr[1])); }
    alpha = 1.f;
    const bool slow = !__all((pmax <= THRL) && (mhat == 0.f));
    if (__builtin_expect(slow, 0)) {
        const float rel = pmax - mhat;
        if (rel > THRL) { mhat += rel; alpha = __builtin_amdgcn_exp2f(-rel); }
#pragma unroll
        for (int r = 0; r < 16; ++r) { p0[r] -= mhat; p1[r] -= mhat; }
    }
#pragma unroll
    for (int r = 0; r < 16; ++r) p0[r] = __builtin_amdgcn_exp2f(p0[r]);
    return slow;
}
constexpr int PP_LDS = 3 * (int)SHM_K + 3 * (int)SHM_V + 8 * 64 * 4;
__device__ __forceinline__ void attn_pp(const bf16_t* Qb, const bf16_t* __restrict__ Kh, const bf16_t* __restrict__ Vh, bf16_t* Ob, const int ldo, int seq, char* lds) {
    int tid = threadIdx.x; asm volatile("" : "+v"(tid));
    const int wid = tid >> 6, lane = tid & 63, r32 = lane & 31, hi = lane >> 5;
    const int half = __builtin_amdgcn_readfirstlane(wid >> 2);
    char* K_lds = lds; char* V_lds = lds + 3 * SHM_K;
    float* ws = (float*)(lds + 3 * SHM_K + 3 * SHM_V) + wid * 64; float* li_l = ws; float* al_l = ws + 32;
    float mhat = 0.f, l_reg = 0; f32x16 o[2] = {}; bf16x8 qr[6];
    const bf16_t* Qw = Qb + (long)(wid * QBLK + r32) * LDQ + hi * 8;
#pragma unroll
    for (int d0 = 0; d0 < 6; ++d0) qr[d0] = *reinterpret_cast<const bf16x8*>(Qw + d0 * 16);
    const int kc0 = tid, kc1 = (tid < 256) ? 512 + tid : tid;
    const int kr0 = kc0 / 12, kcc0 = kc0 % 12, kr1 = kc1 / 12, kcc1 = kc1 % 12;
    const bool k1ok = tid < 256;
    const int vr = tid >> 3, vc = (tid & 7) * 8;
    const int kst0 = KSWZ(kr0, kcc0 * 16), kst1 = KSWZ(kr1, kcc1 * 16), vst = v_st(vr, vc);
    const int vb0 = (int)(uintptr_t)V_lds + v_rd_base(lane);
    bf16x8 gk0, gk1, gv;
    bf16x8 kf[12];
    s16x4 vl[2][4], vh[2][4];
#define KREAD(slot) do { const char* Ks_ = K_lds + (slot) * (int)SHM_K; _Pragma("unroll") for (int d0 = 0; d0 < 6; ++d0) { const int cb = (d0 * 16 + hi * 8) * 2; \
    kf[2 * d0] = *reinterpret_cast<const bf16x8*>(Ks_ + KSWZ(r32, cb)); kf[2 * d0 + 1] = *reinterpret_cast<const bf16x8*>(Ks_ + KSWZ(32 + r32, cb)); } } while (0)
#define VISSUE0(vb_) do { const int vb__ = (vb_); \
    vl[0][0] = tr_read<v_rd_off(0, 0, 0)>(vb__); vh[0][0] = tr_read<v_rd_off(0, 0, 1)>(vb__); vl[0][1] = tr_read<v_rd_off(0, 1, 0)>(vb__); vh[0][1] = tr_read<v_rd_off(0, 1, 1)>(vb__); \
    vl[0][2] = tr_read<v_rd_off(0, 2, 0)>(vb__); vh[0][2] = tr_read<v_rd_off(0, 2, 1)>(vb__); vl[0][3] = tr_read<v_rd_off(0, 3, 0)>(vb__); vh[0][3] = tr_read<v_rd_off(0, 3, 1)>(vb__); } while (0)
#define VISSUE1(vb_) do { const int vb__ = (vb_); \
    vl[1][0] = tr_read<v_rd_off(1, 0, 0)>(vb__); vh[1][0] = tr_read<v_rd_off(1, 0, 1)>(vb__); vl[1][1] = tr_read<v_rd_off(1, 1, 0)>(vb__); vh[1][1] = tr_read<v_rd_off(1, 1, 1)>(vb__); \
    vl[1][2] = tr_read<v_rd_off(1, 2, 0)>(vb__); vh[1][2] = tr_read<v_rd_off(1, 2, 1)>(vb__); vl[1][3] = tr_read<v_rd_off(1, 3, 0)>(vb__); vh[1][3] = tr_read<v_rd_off(1, 3, 1)>(vb__); } while (0)
#define VPK(d, k) (bf16x8){vl[d][k][0], vl[d][k][1], vl[d][k][2], vl[d][k][3], vh[d][k][0], vh[d][k][1], vh[d][k][2], vh[d][k][3]}
#define PVMMA0() do { asm volatile("s_waitcnt lgkmcnt(8)" ::: "memory"); SBAR(); \
    o[0] = __builtin_amdgcn_mfma_f32_32x32x16_bf16(pa0, VPK(0, 0), o[0], 0, 0, 0); o[0] = __builtin_amdgcn_mfma_f32_32x32x16_bf16(pa1, VPK(0, 1), o[0], 0, 0, 0); \
    o[0] = __builtin_amdgcn_mfma_f32_32x32x16_bf16(pa2, VPK(0, 2), o[0], 0, 0, 0); o[0] = __builtin_amdgcn_mfma_f32_32x32x16_bf16(pa3, VPK(0, 3), o[0], 0, 0, 0); SBAR(); } while (0)
#define PVMMA1() do { asm volatile("s_waitcnt lgkmcnt(0)" ::: "memory"); SBAR(); \
    o[1] = __builtin_amdgcn_mfma_f32_32x32x16_bf16(pa0, VPK(1, 0), o[1], 0, 0, 0); o[1] = __builtin_amdgcn_mfma_f32_32x32x16_bf16(pa1, VPK(1, 1), o[1], 0, 0, 0); \
    o[1] = __builtin_amdgcn_mfma_f32_32x32x16_bf16(pa2, VPK(1, 2), o[1], 0, 0, 0); o[1] = __builtin_amdgcn_mfma_f32_32x32x16_bf16(pa3, VPK(1, 3), o[1], 0, 0, 0); } while (0)
#define QKREG(D0A, D0B) do { _Pragma("unroll") for (int d0 = (D0A); d0 < (D0B); ++d0) { p0 = __builtin_amdgcn_mfma_f32_32x32x16_bf16(kf[2 * d0], qr[d0], p0, 0, 0, 0); p1 = __builtin_amdgcn_mfma_f32_32x32x16_bf16(kf[2 * d0 + 1], qr[d0], p1, 0, 0, 0); } } while (0)
#define LOADK(kk0) do { gk0 = *reinterpret_cast<const bf16x8*>(&Kh[(long)((kk0) + kr0) * LDKV + kcc0 * 8]); gk1 = *reinterpret_cast<const bf16x8*>(&Kh[(long)((kk0) + kr1) * LDKV + kcc1 * 8]); } while (0)
#define LOADV(kk0) do { gv = *reinterpret_cast<const bf16x8*>(&Vh[(long)((kk0) + vr) * LDKV + vc]); } while (0)
#define WRITEK(slot) do { *(bf16x8*)(K_lds + (slot) * (int)SHM_K + kst0) = gk0; if (k1ok) *(bf16x8*)(K_lds + (slot) * (int)SHM_K + kst1) = gk1; } while (0)
#define WRITEV(slot) do { *(bf16x8*)(V_lds + (slot) * (int)SHM_V + vst) = gv; } while (0)
#define BARRIER() do { asm volatile("s_waitcnt lgkmcnt(0)" ::: "memory"); __builtin_amdgcn_s_barrier(); asm volatile("" ::: "memory"); SBAR(); } while (0)
#define RESC(a) do { if (__any((a) < 1.f)) { if (hi == 0) al_l[r32] = (a); asm volatile("s_waitcnt lgkmcnt(0)" ::: "memory"); \
    _Pragma("unroll") for (int d = 0; d < 2; ++d) _Pragma("unroll") for (int r = 0; r < 16; ++r) o[d][r] *= al_l[crow(r, hi)]; } } while (0)
    const int NT = seq / KVBLK;
    LOADK(0); asm volatile("s_waitcnt vmcnt(0)" ::: "memory"); WRITEK(0);
    LOADK(KVBLK); asm volatile("s_waitcnt vmcnt(0)" ::: "memory"); WRITEK(1);
    BARRIER();
    KREAD(0);
    LOADK(2 * KVBLK); LOADV(0);
    if (half == 1) BARRIER();
    f32x16 p0, p1; float alpha; bf16x8 pa0, pa1, pa2, pa3;
    int s0 = 0, s1 = 1, s2 = 2;
    for (int i = 0; i < NT; ++i) {
        if (i > 0) VISSUE0(vb0 + s2 * (int)SHM_V);
        SBAR();
        p0 = f32x16{}; p1 = f32x16{};
        QKREG(0, 3);
        SBAR();
        if (i > 0) VISSUE1(vb0 + s2 * (int)SHM_V);
        SBAR();
        QKREG(3, 6);
        SBAR();
        if (i > 0) { PVMMA0(); PVMMA1(); }
        asm volatile("s_waitcnt vmcnt(0)" ::: "memory");
        WRITEK(s2); WRITEV(s0);
        BARRIER();
        if (i + 1 < NT) KREAD(s1);
        { const int tk = (i + 3 < NT) ? i + 3 : NT - 1, tv = (i + 1 < NT) ? i + 1 : NT - 1; LOADK(tk * KVBLK); LOADV(tv * KVBLK); }
        const bool slow_ = partialSM_abs(p0, p1, mhat, alpha);
        finishSM(p0, p1, alpha, l_reg, pa0, pa1, pa2, pa3);
        if (slow_) RESC(alpha);
        BARRIER();
        { const int t = s0; s0 = s1; s1 = s2; s2 = t; }
    }
    VISSUE0(vb0 + s2 * (int)SHM_V); VISSUE1(vb0 + s2 * (int)SHM_V); PVMMA0(); PVMMA1();
    BARRIER();
    if (half == 0) BARRIER();
    if (hi == 0) li_l[r32] = l_reg; asm volatile("s_waitcnt lgkmcnt(0)" ::: "memory");
    float rli[16];
#pragma unroll
    for (int r = 0; r < 16; ++r) rli[r] = __builtin_amdgcn_rcpf(li_l[crow(r, hi)]);
    bf16_t* Ow = Ob + (long)(wid * QBLK) * ldo;
#pragma unroll
    for (int r = 0; r < 16; ++r) { int orow = crow(r, hi);
#pragma unroll
        for (int d0 = 0; d0 < 2; ++d0) Ow[(long)orow * ldo + d0 * 32 + r32] = f2bf(o[d0][r] * rli[r]); }
#undef KREAD
#undef VISSUE0
#undef VISSUE1
#undef VPK
#undef PVMMA0
#undef PVMMA1
#undef QKREG
#undef LOADK
#undef LOADV
#undef WRITEK
#undef WRITEV
#undef BARRIER
#undef RESC
}
#undef KSWZ
#undef SBAR
}

__device__ __forceinline__ float wsrc(const Args& a, int mat, int l, int k, int n) {
    switch (mat) {
    case 0: { const int s = (n < 416) ? n : ((n < 512) ? -1 : n - 96);
              return s < 0 ? 0.f : a.in[2][((size_t)l * DM + k) * INC + s] * a.in[1][l * DM + k]; }
    case 1: return a.in[4][((size_t)l * 256 + k) * 768 + n] * a.in[3][l * 256 + k];
    case 2: { const float g = a.in[5][l * 128 + k];
              return (n < 512 ? a.in[6][((size_t)l * 128 + k) * 512 + n] : a.in[7][((size_t)l * 128 + k) * 512 + (n - 512)]) * g; }
    case 3: return a.in[10][((size_t)l * 512 + k) * 1024 + n];
    case 4: { const int s = ((n >> 2) & 1) * 1024 + (n >> 3) * 4 + (n & 3); return a.in[19][((size_t)l * 512 + k) * 2048 + s]; }
    case 5: return a.in[20][((size_t)l * 1024 + k) * 1024 + n];
    case 6: { const int j = (n >> 3) * 4 + (n & 3); const float* w = ((n >> 2) & 1) ? a.in[23] : a.in[22];
              return w[((size_t)l * 1024 + k) * DFF + j] * a.in[21][l * 1024 + k]; }
    default: return a.in[24][((size_t)l * DFF + k) * 1024 + n];
    }
}
__device__ __forceinline__ void transpose_item(const Args& a, int mat, int l, int Kd, int Nd, bf16_t* WT, LAS float* scr, int item, int lane) {
    const int nblk = Nd / 32, kb = item / nblk, nb = item % nblk, k0 = 64 * kb, n0 = 32 * nb;
    float tv[32];
#pragma unroll
    for (int i = 0; i < 32; ++i) tv[i] = wsrc(a, mat, l, k0 + 2 * i + (lane >> 5), n0 + (lane & 31));
#pragma unroll
    for (int i = 0; i < 32; ++i) scr[(2 * i + (lane >> 5)) * 33 + (lane & 31)] = tv[i];
    asm volatile("s_waitcnt lgkmcnt(0)" ::: "memory");
    const int c = lane & 7;
#pragma unroll
    for (int j = 0; j < 4; ++j) { const int n = (lane >> 3) + 8 * j; const LAS float* s = scr + (8 * c) * 33 + n;
        u32x4 o; o.x = cvt_pk_bf16(s[0 * 33], s[1 * 33]); o.y = cvt_pk_bf16(s[2 * 33], s[3 * 33]); o.z = cvt_pk_bf16(s[4 * 33], s[5 * 33]); o.w = cvt_pk_bf16(s[6 * 33], s[7 * 33]);
        *(u32x4*)(WT + (size_t)(n0 + n) * Kd + k0 + 8 * c) = o; }
    asm volatile("s_waitcnt lgkmcnt(0)" ::: "memory");
}
__device__ __forceinline__ void p0_prologue(const Args& a, LAS unsigned char* lds, int gw, int NGW, int wave, int lane) {
    LAS float* scr = (LAS float*)(lds + wave * 16384);
    constexpr int KD[8] = {1024, 256, 128, 512, 512, 1024, 1024, 2816};
    constexpr int ND[8] = {3072, 768, 1024, 1024, 2048, 1024, 5632, 1024};
    constexpr size_t WO[8] = {W0, W1, W2, W3, W4, W5, W6, W7};
    constexpr int IT[8] = {16 * 96, 4 * 24, 2 * 32, 8 * 32, 8 * 64, 16 * 32, 16 * 176, 44 * 32};
    constexpr int ITL = IT[0] + IT[1] + IT[2] + IT[3] + IT[4] + IT[5] + IT[6] + IT[7];
    for (int it = gw; it < DEPTH * ITL; it += NGW) {
        const int l = it / ITL; int r = it % ITL;
#pragma unroll
        for (int mt = 0; mt < 8; ++mt) {
            if (r >= 0 && r < IT[mt]) transpose_item(a, mt, l, KD[mt], ND[mt], (bf16_t*)(a.ws + WS_W + (size_t)l * W_LAYER + WO[mt]), scr, r, lane);
            r -= IT[mt];
        }
    }
    const int gt = gw * 64 + lane;
    if (gt < DEPTH * 2 * NG * ST) {
        const int ldg = gt / ST;
        const float lre = a.in[11][gt], lim = a.in[12][gt];
        const float dt = expf(a.in[13][ldg]);
        const float ar = lre * dt, ai = lim * dt;
        const float ea = expf(ar), cb = cosf(ai), sb = sinf(ai), sh = sinf(0.5f * ai);
        const float lbr = ea * cb, lbi = ea * sb;
        const float nr = expm1f(ar) * cb - 2.f * sh * sh, ni = ea * sb;
        const float den = 1.f / (lre * lre + lim * lim);
        const float cr = (nr * lre + ni * lim) * den, ci = (ni * lre - nr * lim) * den;
        ((f32x2*)(a.ws + WS_LAMB))[gt] = (f32x2){lbr, lbi};
        f32x2* bb = (f32x2*)(a.ws + WS_BBAR) + (size_t)gt * 16;
#pragma unroll
        for (int c = 0; c < 16; ++c) { const float br = a.in[14][(size_t)gt * 16 + c], bi = a.in[15][(size_t)gt * 16 + c];
            bb[c] = (f32x2){cr * br - ci * bi, cr * bi + ci * br}; }
    }
}

__device__ __forceinline__ void norm_row2(const float* xa, bf16_t* oa, const float* xb, bf16_t* ob, int lane) {
    const f32x4* ra = (const f32x4*)xa + lane; const f32x4* rb = (const f32x4*)xb + lane;
    f32x4 va[4], vb[4]; float sa = 0.f, sb = 0.f;
#pragma unroll
    for (int j = 0; j < 4; ++j) { va[j] = ra[64 * j]; vb[j] = rb[64 * j]; }
#pragma unroll
    for (int j = 0; j < 4; ++j) { sa += (va[j].x * va[j].x + va[j].y * va[j].y) + (va[j].z * va[j].z + va[j].w * va[j].w); sb += (vb[j].x * vb[j].x + vb[j].y * vb[j].y) + (vb[j].z * vb[j].z + vb[j].w * vb[j].w); }
#pragma unroll
    for (int o = 1; o < 64; o <<= 1) { sa += __shfl_xor(sa, o); sb += __shfl_xor(sb, o); }
    const float ia = 1.f / sqrtf(sa * (1.f / DM) + EPS), ib = 1.f / sqrtf(sb * (1.f / DM) + EPS);
    u32x2* pa = (u32x2*)oa + lane; u32x2* pb = (u32x2*)ob + lane;
#pragma unroll
    for (int j = 0; j < 4; ++j) { u32x2 w; w.x = cvt_pk_bf16(va[j].x * ia, va[j].y * ia); w.y = cvt_pk_bf16(va[j].z * ia, va[j].w * ia); pa[64 * j] = w;
        u32x2 z; z.x = cvt_pk_bf16(vb[j].x * ib, vb[j].y * ib); z.y = cvt_pk_bf16(vb[j].z * ib, vb[j].w * ib); pb[64 * j] = z; }
}
__device__ __forceinline__ void norm_row(const float* xrow, bf16_t* orow, int lane) {
    const f32x4* xr = (const f32x4*)xrow + lane;
    f32x4 v[4]; float s = 0.f;
#pragma unroll
    for (int j = 0; j < 4; ++j) { v[j] = xr[64 * j]; s += (v[j].x * v[j].x + v[j].y * v[j].y) + (v[j].z * v[j].z + v[j].w * v[j].w); }
    const float rinv = 1.f / sqrtf(wave_sum(s) * (1.f / DM) + EPS);
    u32x2* o8 = (u32x2*)orow + lane;
#pragma unroll
    for (int j = 0; j < 4; ++j) { u32x2 w; w.x = cvt_pk_bf16(v[j].x * rinv, v[j].y * rinv); w.y = cvt_pk_bf16(v[j].z * rinv, v[j].w * rinv); o8[64 * j] = w; }
}

__device__ __forceinline__ void sincos_d(double a, float& s, float& c) {
    const double TWO_OVER_PI = 0.63661977236758134308, PIO2_HI = 1.57079632679489655800e+00, PIO2_LO = 6.12323399573676603587e-17;
    const double kq = rint(a * TWO_OVER_PI);
    double y = fma(-kq, PIO2_HI, a); y = fma(-kq, PIO2_LO, y);
    const double y2 = y * y;
    double sp = 1.0 / 6227020800.0; sp = fma(sp, y2, -1.0 / 39916800.0); sp = fma(sp, y2, 1.0 / 362880.0); sp = fma(sp, y2, -1.0 / 5040.0); sp = fma(sp, y2, 1.0 / 120.0); sp = fma(sp, y2, -1.0 / 6.0); sp = fma(sp, y2, 1.0);
    const double sy = y * sp;
    double cp = 1.0 / 479001600.0; cp = fma(cp, y2, -1.0 / 3628800.0); cp = fma(cp, y2, 1.0 / 40320.0); cp = fma(cp, y2, -1.0 / 720.0); cp = fma(cp, y2, 1.0 / 24.0); cp = fma(cp, y2, -0.5); cp = fma(cp, y2, 1.0);
    const int q = ((int)kq) & 3;
    const double ss = (q == 0) ? sy : (q == 1) ? cp : (q == 2) ? -sy : -cp;
    const double cc = (q == 0) ? cp : (q == 1) ? -sy : (q == 2) ? -cp : sy;
    s = (float)ss; c = (float)cc;
}

__device__ __forceinline__ void unpack8(const u32x4 w, float* v) { v[0] = bf_lo(w.x); v[1] = bf_hi(w.x); v[2] = bf_lo(w.y); v[3] = bf_hi(w.y); v[4] = bf_lo(w.z); v[5] = bf_hi(w.z); v[6] = bf_lo(w.w); v[7] = bf_hi(w.w); }
__device__ __forceinline__ u32x4 pack8(const float* v) { u32x4 w; w.x = cvt_pk_bf16(v[0], v[1]); w.y = cvt_pk_bf16(v[2], v[3]); w.z = cvt_pk_bf16(v[4], v[5]); w.w = cvt_pk_bf16(v[6], v[7]); return w; }
__device__ __forceinline__ void postproc_row(const Args& a, int l, int row, int lane) {
    const bf16_t* P = (const bf16_t*)(a.ws + WS_PROJ) + (size_t)row * PROJ_N;
    bf16_t* Qr = (bf16_t*)(a.ws + WS_Q) + (size_t)row * LDQ; bf16_t* KVr = (bf16_t*)(a.ws + WS_KV) + (size_t)row * LDKV;
    const int sub = lane & 7, head = lane >> 3; const bool rp = sub < 2;
    const u32x2 cqw = *(const u32x2*)(P + lane * 4);
    const unsigned ckw = *(const unsigned*)(P + 256 + lane * 2);
    const u32x4 q0w = *(const u32x4*)(Qr + head * 96 + sub * 8);
    const u32x4 k0w = *(const u32x4*)(KVr + head * 96 + sub * 8);
    u32x4 q1w = {0, 0, 0, 0}, q2w = {0, 0, 0, 0}, r1w = {0, 0, 0, 0}, r2w = {0, 0, 0, 0};
    if (rp) { q1w = *(const u32x4*)(Qr + head * 96 + 64 + sub * 8); q2w = *(const u32x4*)(Qr + head * 96 + 80 + sub * 8);
              r1w = *(const u32x4*)(P + 384 + sub * 8); r2w = *(const u32x4*)(P + 384 + 16 + sub * 8); }
    u32x4* vp = (u32x4*)(KVr + 768 + lane * 8); const u32x4 vw = *vp;
    const f32x4 gq0a = *(const f32x4*)(a.in[8] + l * 96 + sub * 8), gq0b = *(const f32x4*)(a.in[8] + l * 96 + sub * 8 + 4);
    const f32x4 gk0a = *(const f32x4*)(a.in[9] + l * 96 + sub * 8), gk0b = *(const f32x4*)(a.in[9] + l * 96 + sub * 8 + 4);
    const int so = rp ? sub * 8 : 0;
    const f32x4 gq1a = *(const f32x4*)(a.in[8] + l * 96 + 64 + so), gq1b = *(const f32x4*)(a.in[8] + l * 96 + 64 + so + 4);
    const f32x4 gq2a = *(const f32x4*)(a.in[8] + l * 96 + 80 + so), gq2b = *(const f32x4*)(a.in[8] + l * 96 + 80 + so + 4);
    const f32x4 gk1a = *(const f32x4*)(a.in[9] + l * 96 + 64 + so), gk1b = *(const f32x4*)(a.in[9] + l * 96 + 64 + so + 4);
    const f32x4 gk2a = *(const f32x4*)(a.in[9] + l * 96 + 80 + so), gk2b = *(const f32x4*)(a.in[9] + l * 96 + 80 + so + 4);
    float s1 = bf_lo(cqw.x) * bf_lo(cqw.x) + bf_hi(cqw.x) * bf_hi(cqw.x) + bf_lo(cqw.y) * bf_lo(cqw.y) + bf_hi(cqw.y) * bf_hi(cqw.y);
    float s2 = bf_lo(ckw) * bf_lo(ckw) + bf_hi(ckw) * bf_hi(ckw);
#pragma unroll
    for (int o = 1; o < 64; o <<= 1) { s1 += __shfl_xor(s1, o); s2 += __shfl_xor(s2, o); }
    const float sq = 1.f / sqrtf(s1 * (1.f / 256.f) + EPS), skv = 1.f / sqrtf(s2 * (1.f / 128.f) + EPS);
    const int pos = row & (SEQ - 1);
    float cs[8], sn[8];
#pragma unroll
    for (int e = 0; e < 8; ++e) { cs[e] = 1.f; sn[e] = 0.f; }
    if (rp) {
#pragma unroll
        for (int e = 0; e < 8; ++e) { const int i3 = e & 3; const int i2 = sub * 2 + (e >> 2);
            const double base = (i3 == 0) ? 1.0 : (i3 == 1) ? 0.5623413251903491 : (i3 == 2) ? 0.31622776601683794 : 0.17782794100389228;
            const double sc = (i2 == 0) ? 1.0 : (i2 == 1) ? 0.1 : (i2 == 2) ? 0.01 : 0.001;
            const float invf = (float)(base * sc); const float ang = (float)pos * invf;
            sincos_d((double)ang, sn[e], cs[e]); } }
    float g0[8] = {gq0a.x, gq0a.y, gq0a.z, gq0a.w, gq0b.x, gq0b.y, gq0b.z, gq0b.w};
    float g1[8] = {gq1a.x, gq1a.y, gq1a.z, gq1a.w, gq1b.x, gq1b.y, gq1b.z, gq1b.w};
    float g2[8] = {gq2a.x, gq2a.y, gq2a.z, gq2a.w, gq2b.x, gq2b.y, gq2b.z, gq2b.w};
    { float v0[8], v1[8], v2[8]; unpack8(q0w, v0); unpack8(q1w, v1); unpack8(q2w, v2); float ss = 0.f;
#pragma unroll
      for (int e = 0; e < 8; ++e) { v0[e] *= sq; v1[e] *= sq; v2[e] *= sq; ss += v0[e] * v0[e] + v1[e] * v1[e] + v2[e] * v2[e]; }
      ss += __shfl_xor(ss, 1); ss += __shfl_xor(ss, 2); ss += __shfl_xor(ss, 4);
      const float rinv = 1.f / sqrtf(ss * (1.f / 96.f) + EPS) * (att::SCALE * 1.4426950408889634f);
#pragma unroll
      for (int e = 0; e < 8; ++e) { v0[e] *= rinv * g0[e]; const float x1 = v1[e] * rinv * g1[e], x2 = v2[e] * rinv * g2[e]; v1[e] = x1 * cs[e] - x2 * sn[e]; v2[e] = x2 * cs[e] + x1 * sn[e]; }
      *(u32x4*)(Qr + head * 96 + sub * 8) = pack8(v0);
      if (rp) { *(u32x4*)(Qr + head * 96 + 64 + sub * 8) = pack8(v1); *(u32x4*)(Qr + head * 96 + 80 + sub * 8) = pack8(v2); } }
    { float h0[8] = {gk0a.x, gk0a.y, gk0a.z, gk0a.w, gk0b.x, gk0b.y, gk0b.z, gk0b.w};
      float h1[8] = {gk1a.x, gk1a.y, gk1a.z, gk1a.w, gk1b.x, gk1b.y, gk1b.z, gk1b.w};
      float h2[8] = {gk2a.x, gk2a.y, gk2a.z, gk2a.w, gk2b.x, gk2b.y, gk2b.z, gk2b.w};
      float v0[8], v1[8], v2[8]; unpack8(k0w, v0); unpack8(r1w, v1); unpack8(r2w, v2); float ss = 0.f;
#pragma unroll
      for (int e = 0; e < 8; ++e) { v0[e] *= skv; ss += v0[e] * v0[e] + v1[e] * v1[e] + v2[e] * v2[e]; }
      ss += __shfl_xor(ss, 1); ss += __shfl_xor(ss, 2); ss += __shfl_xor(ss, 4);
      const float rinv = 1.f / sqrtf(ss * (1.f / 96.f) + EPS);
#pragma unroll
      for (int e = 0; e < 8; ++e) { v0[e] *= rinv * h0[e]; const float x1 = v1[e] * rinv * h1[e], x2 = v2[e] * rinv * h2[e]; v1[e] = x1 * cs[e] - x2 * sn[e]; v2[e] = x2 * cs[e] + x1 * sn[e]; }
      *(u32x4*)(KVr + head * 96 + sub * 8) = pack8(v0);
      if (rp) { *(u32x4*)(KVr + head * 96 + 64 + sub * 8) = pack8(v1); *(u32x4*)(KVr + head * 96 + 80 + sub * 8) = pack8(v2); } }
    { float v[8]; unpack8(vw, v);
#pragma unroll
      for (int e = 0; e < 8; ++e) v[e] *= skv;
      *vp = pack8(v); }
}

template <bool FULL, int DIR>
__device__ __forceinline__ void s5_dir(const Args& a, int l, int b, int g, int ch, int lane) {
    const bf16_t* PROJ = (const bf16_t*)(a.ws + WS_PROJ);
    const int ldg = (l * 2 + DIR) * NG + g, sidx = ldg * ST + lane;
    const f32x2 lam = ((const f32x2*)(a.ws + WS_LAMB))[sidx];
    float bre[16], bim[16];
    { const f32x4* bb = (const f32x4*)((const f32x2*)(a.ws + WS_BBAR) + (size_t)sidx * 16);
#pragma unroll
      for (int c2 = 0; c2 < 8; ++c2) { const f32x4 t = bb[c2]; bre[2 * c2] = t.x; bim[2 * c2] = t.y; bre[2 * c2 + 1] = t.z; bim[2 * c2 + 1] = t.w; } }
    float cre[16], cim[16];
    if (FULL) {
#pragma unroll
        for (int c = 0; c < 16; ++c) { cre[c] = a.in[16][((size_t)ldg * 16 + c) * ST + lane]; cim[c] = -a.in[17][((size_t)ldg * 16 + c) * ST + lane]; } }
    float sr = 0.f, si = 0.f;
    f32x2* E = (f32x2*)(a.ws + WS_E) + ((size_t)((b * NG + g) * 2 + DIR) * NCH) * ST + lane;
    if (FULL) {
        float pr = lam.x, pi = lam.y;
#pragma unroll
        for (int i = 0; i < 9; ++i) { const float t = pr * pr - pi * pi; pi = 2.f * pr * pi; pr = t; }
        if (DIR == 0) { for (int j = 0; j < ch; ++j) { const f32x2 e = E[(size_t)j * ST]; const float t = pr * sr - pi * si + e.x; si = pr * si + pi * sr + e.y; sr = t; } }
        else { for (int j = NCH - 1; j > ch; --j) { const f32x2 e = E[(size_t)j * ST]; const float t = pr * sr - pi * si + e.x; si = pr * si + pi * sr + e.y; sr = t; } }
    }
    const size_t row0 = (size_t)b * SEQ + (size_t)ch * CHUNK;
    for (int tile = 0; tile < CHUNK / 64; ++tile) {
        const int tt = (DIR == 0) ? tile : (CHUNK / 64 - 1 - tile);
        const size_t tok0 = row0 + (size_t)tt * 64;
        const u32x4* up = (const u32x4*)(PROJ + (tok0 + lane) * PROJ_N + 512 + g * 16);
        const u32x4 ua = up[0], ub = up[1];
        for (int t4 = 0; t4 < 16; ++t4) {
            float part[64];
#pragma unroll
            for (int q = 0; q < 4; ++q) {
                const int tl = t4 * 4 + q, tsel = (DIR == 0) ? tl : 63 - tl;
                unsigned w[8];
                w[0] = __builtin_amdgcn_readlane(ua.x, tsel); w[1] = __builtin_amdgcn_readlane(ua.y, tsel); w[2] = __builtin_amdgcn_readlane(ua.z, tsel); w[3] = __builtin_amdgcn_readlane(ua.w, tsel);
                w[4] = __builtin_amdgcn_readlane(ub.x, tsel); w[5] = __builtin_amdgcn_readlane(ub.y, tsel); w[6] = __builtin_amdgcn_readlane(ub.z, tsel); w[7] = __builtin_amdgcn_readlane(ub.w, tsel);
                float bur = 0.f, bui = 0.f;
#pragma unroll
                for (int c2 = 0; c2 < 8; ++c2) { const float u0 = bf_lo(w[c2]), u1 = bf_hi(w[c2]);
                    bur = fmaf(bre[2 * c2], u0, bur); bui = fmaf(bim[2 * c2], u0, bui); bur = fmaf(bre[2 * c2 + 1], u1, bur); bui = fmaf(bim[2 * c2 + 1], u1, bui); }
                const float nr = lam.x * sr - lam.y * si + bur, ni = lam.x * si + lam.y * sr + bui; sr = nr; si = ni;
                if (FULL) { constexpr int dummy = 0; (void)dummy; const int slot = (DIR == 0) ? q : 3 - q;
#pragma unroll
                    for (int c = 0; c < 16; ++c) part[slot * 16 + c] = cre[c] * sr + cim[c] * si; }
            }
            if (FULL) {
#define RSTEP(NK, XM) { const bool upb = (lane & XM) != 0; _Pragma("unroll") for (int i = 0; i < NK; ++i) { const float keep = upb ? part[i + NK] : part[i]; const float send = upb ? part[i] : part[i + NK]; part[i] = keep + __shfl_xor(send, XM); } }
                RSTEP(32, 32) RSTEP(16, 16) RSTEP(8, 8) RSTEP(4, 4) RSTEP(2, 2) RSTEP(1, 1)
#undef RSTEP
                const int tb = (DIR == 0) ? t4 * 4 : 60 - t4 * 4;
                const size_t row = tok0 + tb + (lane >> 4); const int c = lane & 15;
                float* yf = (float*)(a.ws + WS_YF) + row * 512 + g * 16 + c;
                if (DIR == 0) { *yf = part[0]; }
                else { const float u = bf2f(PROJ[row * PROJ_N + 512 + g * 16 + c]);
                    const float y = part[0] + *yf + a.in[18][l * 512 + g * 16 + c] * u;
                    const float z2 = 1.5957691216057308f * (y + 0.044715f * y * y * y);
                    const float ge = y * (1.f - __builtin_amdgcn_rcpf(1.f + __expf(z2)));
                    ((bf16_t*)(a.ws + WS_YG))[row * 512 + g * 16 + c] = f2bf(ge); }
            }
        }
    }
    if (!FULL) E[(size_t)ch * ST] = (f32x2){sr, si};
}
constexpr int S5_ROWB = 272, S5_LDS_WAVE = 32 * S5_ROWB;
template <bool FULL, int DIR>
__device__ __forceinline__ void s5m_dir(const Args& a, int l, int b, int g, int ch, int lane, LAS unsigned char* sl) {
    const bf16_t* PROJ = (const bf16_t*)(a.ws + WS_PROJ);
    const int ldg = (l * 2 + DIR) * NG + g, p1 = lane & 31, hi = lane >> 5;
    float lr[2], li[2], p4r[2], p4i[2];
#pragma unroll
    for (int s = 0; s < 2; ++s) { const f32x2 lm = ((const f32x2*)(a.ws + WS_LAMB))[ldg * ST + 32 * s + p1]; lr[s] = lm.x; li[s] = lm.y;
        const float q2r = lm.x * lm.x - lm.y * lm.y, q2i = 2.f * lm.x * lm.y; p4r[s] = q2r * q2r - q2i * q2i; p4i[s] = 2.f * q2r * q2i; }
    bf16x8 bfr[4];
#pragma unroll
    for (int j = 0; j < 4; ++j) { const f32x4* bb = (const f32x4*)((const f32x2*)(a.ws + WS_BBAR) + ((size_t)(ldg * ST + 32 * (j & 1) + p1)) * 16 + 8 * hi);
        const f32x4 t0 = bb[0], t1 = bb[1], t2 = bb[2], t3 = bb[3];
        u32x4 w;
        if ((j >> 1) == 0) { w.x = cvt_pk_bf16(t0.x, t0.z); w.y = cvt_pk_bf16(t1.x, t1.z); w.z = cvt_pk_bf16(t2.x, t2.z); w.w = cvt_pk_bf16(t3.x, t3.z); }
        else               { w.x = cvt_pk_bf16(t0.y, t0.w); w.y = cvt_pk_bf16(t1.y, t1.w); w.z = cvt_pk_bf16(t2.y, t2.w); w.w = cvt_pk_bf16(t3.y, t3.w); }
        bfr[j] = __builtin_bit_cast(bf16x8, w); }
    bf16x8 cfr[4];
    if (FULL) { const int c = lane & 15, kq = lane >> 4;
#pragma unroll
        for (int ks = 0; ks < 4; ++ks) { const int n0 = 32 * ks + 8 * kq;
            const float* cp = (ks < 2) ? (a.in[16] + ((size_t)ldg * 16 + c) * ST + n0) : (a.in[17] + ((size_t)ldg * 16 + c) * ST + (n0 - 64));
            const f32x4 t0 = ((const f32x4*)cp)[0], t1 = ((const f32x4*)cp)[1]; const float sg = (ks < 2) ? 1.f : -1.f;
            u32x4 w; w.x = cvt_pk_bf16(sg * t0.x, sg * t0.y); w.y = cvt_pk_bf16(sg * t0.z, sg * t0.w); w.z = cvt_pk_bf16(sg * t1.x, sg * t1.y); w.w = cvt_pk_bf16(sg * t1.z, sg * t1.w);
            cfr[ks] = __builtin_bit_cast(bf16x8, w); } }
    float cr[2] = {0.f, 0.f}, ci[2] = {0.f, 0.f};
    float wr_[2][16], wi_[2][16], p32r[2], p32i[2];
    if (!FULL) {
#pragma unroll
        for (int s = 0; s < 2; ++s) {
            float ar[4], ai[4], br[4], bi[4];
            ar[0] = 1.f; ai[0] = 0.f;
#pragma unroll
            for (int j = 1; j < 4; ++j) { ar[j] = ar[j - 1] * lr[s] - ai[j - 1] * li[s]; ai[j] = ar[j - 1] * li[s] + ai[j - 1] * lr[s]; }
            const float l8r = p4r[s] * p4r[s] - p4i[s] * p4i[s], l8i = 2.f * p4r[s] * p4i[s];
            br[0] = 1.f; bi[0] = 0.f;
#pragma unroll
            for (int m = 1; m < 4; ++m) { br[m] = br[m - 1] * l8r - bi[m - 1] * l8i; bi[m] = br[m - 1] * l8i + bi[m - 1] * l8r; }
            const float hr = hi ? 1.f : p4r[s], hi_ = hi ? 0.f : p4i[s];
#pragma unroll
            for (int r = 0; r < 16; ++r) { const int j = 3 - (r & 3), m = 3 - (r >> 2);
                const float tr = ar[j] * br[m] - ai[j] * bi[m], ti = ar[j] * bi[m] + ai[j] * br[m];
                wr_[s][r] = tr * hr - ti * hi_; wi_[s][r] = tr * hi_ + ti * hr; }
            const float l16r = l8r * l8r - l8i * l8i, l16i = 2.f * l8r * l8i;
            p32r[s] = l16r * l16r - l16i * l16i; p32i[s] = 2.f * l16r * l16i;
        }
    }
    f32x2* E = (f32x2*)(a.ws + WS_E) + ((size_t)((b * NG + g) * 2 + DIR) * NCH) * ST;
    if (FULL) {
#pragma unroll
        for (int s = 0; s < 2; ++s) { float pr = lr[s], pi = li[s];
#pragma unroll
            for (int i = 0; i < 9; ++i) { const float t = pr * pr - pi * pi; pi = 2.f * pr * pi; pr = t; }
            if (DIR == 0) { for (int j = 0; j < ch; ++j) { const f32x2 e = E[(size_t)j * ST + 32 * s + p1]; const float t = pr * cr[s] - pi * ci[s] + e.x; ci[s] = pr * ci[s] + pi * cr[s] + e.y; cr[s] = t; } }
            else { for (int j = NCH - 1; j > ch; --j) { const f32x2 e = E[(size_t)j * ST + 32 * s + p1]; const float t = pr * cr[s] - pi * ci[s] + e.x; ci[s] = pr * ci[s] + pi * cr[s] + e.y; cr[s] = t; } } }
    }
    const size_t row0 = (size_t)b * SEQ + (size_t)ch * CHUNK;
    bf16x8 ua_next;
    { const size_t tk0 = row0 + (size_t)((DIR == 0) ? 0 : (CHUNK / 32 - 1)) * 32; const size_t tkA = (DIR == 0) ? tk0 + p1 : tk0 + 31 - p1;
      ua_next = *(const bf16x8*)(PROJ + tkA * PROJ_N + 512 + g * 16 + 8 * hi); }
    for (int tile = 0; tile < CHUNK / 32; ++tile) {
        const int tt = (DIR == 0) ? tile : (CHUNK / 32 - 1 - tile);
        const size_t tok0 = row0 + (size_t)tt * 32;
        const bf16x8 ua = ua_next;
        { const int tn = (tile + 1 < CHUNK / 32) ? tile + 1 : tile; const int ttn = (DIR == 0) ? tn : (CHUNK / 32 - 1 - tn);
          const size_t tk0 = row0 + (size_t)ttn * 32; const size_t tkA = (DIR == 0) ? tk0 + p1 : tk0 + 31 - p1;
          ua_next = *(const bf16x8*)(PROJ + tkA * PROJ_N + 512 + g * 16 + 8 * hi); }
        f32x16 acc[4];
#pragma unroll
        for (int j = 0; j < 4; ++j) { f32x16 z = {}; acc[j] = __builtin_amdgcn_mfma_f32_32x32x16_bf16(ua, bfr[j], z, 0, 0, 0); }
        if (!FULL) {
#pragma unroll
            for (int s = 0; s < 2; ++s) { float e0r = 0.f, e0i = 0.f, e1r = 0.f, e1i = 0.f;
#pragma unroll
                for (int r = 0; r < 16; r += 2) {
                    e0r += wr_[s][r] * acc[s][r] - wi_[s][r] * acc[2 + s][r];             e0i += wr_[s][r] * acc[2 + s][r] + wi_[s][r] * acc[s][r];
                    e1r += wr_[s][r + 1] * acc[s][r + 1] - wi_[s][r + 1] * acc[2 + s][r + 1]; e1i += wr_[s][r + 1] * acc[2 + s][r + 1] + wi_[s][r + 1] * acc[s][r + 1]; }
                float er_ = e0r + e1r, ei_ = e0i + e1i;
                { auto rr = __builtin_amdgcn_permlane32_swap(__float_as_uint(er_), __float_as_uint(er_), false, false); er_ = __uint_as_float(rr[0]) + __uint_as_float(rr[1]); }
                { auto ri = __builtin_amdgcn_permlane32_swap(__float_as_uint(ei_), __float_as_uint(ei_), false, false); ei_ = __uint_as_float(ri[0]) + __uint_as_float(ri[1]); }
                const float t = p32r[s] * cr[s] - p32i[s] * ci[s] + er_; ci[s] = p32r[s] * ci[s] + p32i[s] * cr[s] + ei_; cr[s] = t; }
            continue;
        }
        float er[2][4], ei[2][4], eor[2][4], eoi[2][4];
#pragma unroll
        for (int s = 0; s < 2; ++s)
#pragma unroll
            for (int q = 0; q < 4; ++q) { float xr = acc[s][4 * q], xi = acc[2 + s][4 * q];
#pragma unroll
                for (int i = 1; i < 4; ++i) { const float t = lr[s] * xr - li[s] * xi + acc[s][4 * q + i]; xi = lr[s] * xi + li[s] * xr + acc[2 + s][4 * q + i]; xr = t; }
                { auto rr = __builtin_amdgcn_permlane32_swap(__float_as_uint(xr), __float_as_uint(xr), false, false); er[s][q] = __uint_as_float(rr[0]); eor[s][q] = __uint_as_float(rr[1]); }
                { auto ri = __builtin_amdgcn_permlane32_swap(__float_as_uint(xi), __float_as_uint(xi), false, false); ei[s][q] = __uint_as_float(ri[0]); eoi[s][q] = __uint_as_float(ri[1]); } }
        float cinr[2][4], cini[2][4];
#pragma unroll
        for (int s = 0; s < 2; ++s) { float c_r = cr[s], c_i = ci[s];
#pragma unroll
            for (int q = 0; q < 4; ++q) {
                const float c0r = c_r, c0i = c_i;
                { const float t = p4r[s] * c_r - p4i[s] * c_i + er[s][q]; c_i = p4r[s] * c_i + p4i[s] * c_r + ei[s][q]; c_r = t; }
                const float c1r = c_r, c1i = c_i;
                { const float t = p4r[s] * c_r - p4i[s] * c_i + eor[s][q]; c_i = p4r[s] * c_i + p4i[s] * c_r + eoi[s][q]; c_r = t; }
                cinr[s][q] = hi ? c1r : c0r; cini[s][q] = hi ? c1i : c0i; }
            cr[s] = c_r; ci[s] = c_i; }
        if (FULL) {
#pragma unroll
            for (int s = 0; s < 2; ++s)
#pragma unroll
                for (int q = 0; q < 4; ++q) { float xr = cinr[s][q], xi = cini[s][q];
#pragma unroll
                    for (int i = 0; i < 4; ++i) { const float t = lr[s] * xr - li[s] * xi + acc[s][4 * q + i]; xi = lr[s] * xi + li[s] * xr + acc[2 + s][4 * q + i]; xr = t;
                        acc[s][4 * q + i] = xr; acc[2 + s][4 * q + i] = xi; } }
#pragma unroll
            for (int j = 0; j < 4; ++j)
#pragma unroll
                for (int r = 0; r < 16; r += 2) { const unsigned w2 = cvt_pk_bf16(acc[j][r], acc[j][r + 1]);
                    const int rho = (r & 3) + 8 * (r >> 2) + 4 * hi; const int rw0 = (DIR == 0) ? rho : 31 - rho, rw1 = (DIR == 0) ? rho + 1 : 30 - rho;
                    *(LAS bf16_t*)(sl + rw0 * S5_ROWB + (32 * j + p1) * 2) = (bf16_t)(w2 & 0xffffu);
                    *(LAS bf16_t*)(sl + rw1 * S5_ROWB + (32 * j + p1) * 2) = (bf16_t)(w2 >> 16); }
#pragma unroll
            for (int mt = 0; mt < 2; ++mt) { f32x4 y = {0.f, 0.f, 0.f, 0.f};
#pragma unroll
                for (int ks = 0; ks < 4; ++ks) { const bf16x8 af = *(const LAS bf16x8*)(sl + (16 * mt + (lane & 15)) * S5_ROWB + (32 * ks + 8 * (lane >> 4)) * 2);
                    y = __builtin_amdgcn_mfma_f32_16x16x32_bf16(af, cfr[ks], y, 0, 0, 0); }
                const int c = lane & 15;
#pragma unroll
                for (int rg = 0; rg < 4; ++rg) { const size_t row = tok0 + 16 * mt + 4 * (lane >> 4) + rg;
                    float* yf = (float*)(a.ws + WS_YF) + row * 512 + g * 16 + c;
                    if (DIR == 0) { *yf = y[rg]; }
                    else { const float u = bf2f(PROJ[row * PROJ_N + 512 + g * 16 + c]);
                        const float yy = y[rg] + *yf + a.in[18][l * 512 + g * 16 + c] * u;
                        const float z2 = 1.5957691216057308f * (yy + 0.044715f * yy * yy * yy);
                        const float ge = yy * (1.f - __builtin_amdgcn_rcpf(1.f + __expf(z2)));
                        ((bf16_t*)(a.ws + WS_YG))[row * 512 + g * 16 + c] = f2bf(ge); } } }
        }
    }
    if (!FULL) { if (hi == 0) {
#pragma unroll
        for (int s = 0; s < 2; ++s) E[(size_t)ch * ST + 32 * s + p1] = (f32x2){cr[s], ci[s]}; } }
}
#ifndef S5_VALU
#define S5_VALU 0
#endif
template <bool FULL>
__device__ __forceinline__ void s5_item(const Args& a, int l, int item, int lane, LAS unsigned char* sl) {
    const int ch = item & (NCH - 1), g = (item >> 5) & 31, b = item >> 10;
#if S5_VALU
    s5_dir<FULL, 0>(a, l, b, g, ch, lane);
    s5_dir<FULL, 1>(a, l, b, g, ch, lane);
#else
    s5m_dir<FULL, 0>(a, l, b, g, ch, lane, sl);
    s5m_dir<FULL, 1>(a, l, b, g, ch, lane, sl);
#endif
}


#define XB_TMO      128
#define XB_XCNT(j)  (256  + 64 * (j))
#define XB_XSUB(j)  (1280 + 64 * (j))
#define XB_XGEN(j)  (2304 + 64 * (j))
#define XB_TOP      3328
#define XB_TOPGEN   3392
#define XCD_BAR_WORDS 3456
#define XB_SPIN_CAP (1u << 18)
__device__ __forceinline__ unsigned xb_ld(unsigned* p)              { return __hip_atomic_load(p, __ATOMIC_RELAXED, __HIP_MEMORY_SCOPE_AGENT); }
__device__ __forceinline__ unsigned xb_add(unsigned* p, unsigned v) { return __hip_atomic_fetch_add(p, v, __ATOMIC_RELAXED, __HIP_MEMORY_SCOPE_AGENT); }
__device__ __forceinline__ unsigned xb_xcc_id() { return (unsigned)__builtin_amdgcn_s_getreg((3 << 11) | 20) & 0xFu; }
#define XB_SPIN(cond, bar) do { unsigned _sp = 0; while (cond) { __builtin_amdgcn_s_sleep(1); \
    if ((++_sp & 255u) == 0u) { if (xb_ld(&(bar)[XB_TMO])) break; if (_sp > XB_SPIN_CAP) { atomicAdd(&(bar)[XB_TMO], 1u); break; } } } } while (0)
struct XcdBarrier { unsigned* bar; unsigned x; volatile LAS unsigned* st; };
__device__ __forceinline__ XcdBarrier xcd_barrier_post(unsigned* bar, volatile LAS unsigned* st) {
    XcdBarrier b; b.bar = bar; b.x = xb_xcc_id(); b.st = st;
    if (threadIdx.x == 0) (void)xb_add(&bar[XB_XCNT(b.x)], 1u);
    return b;
}
__device__ __forceinline__ void xcd_barrier_complete(unsigned* bar, unsigned x, unsigned& nloc, unsigned& nx) {
    const unsigned G = gridDim.x * gridDim.y * gridDim.z;
    unsigned sum, cnt, mine, sp = 0u;
    for (;;) {
        sum = 0u; cnt = 0u; mine = 0u;
#pragma unroll
        for (unsigned j = 0; j < 16; ++j) { const unsigned c = xb_ld(&bar[XB_XCNT(j)]); sum += c; cnt += (c > 0u) ? 1u : 0u; mine = (j == x) ? c : mine; }
        if (sum == G) break;
        __builtin_amdgcn_s_sleep(1);
        if ((++sp & 255u) == 0u) { if (xb_ld(&bar[XB_TMO])) break; if (sp > XB_SPIN_CAP) { atomicAdd(&bar[XB_TMO], 1u); break; } }
    }
    nloc = mine > 0u ? mine : 1u; nx = cnt > 0u ? cnt : 1u;
}
__device__ __forceinline__ void xcd_barrier(const XcdBarrier& b) {
    asm volatile("s_waitcnt vmcnt(0)" ::: "memory");
    __syncthreads();
    if (threadIdx.x == 0) {
        unsigned* bar = b.bar;
        __builtin_amdgcn_s_waitcnt(0);
        unsigned nloc = b.st[0], nx = b.st[1];
        if (nloc == 0u) { xcd_barrier_complete(bar, b.x, nloc, nx); b.st[0] = nloc; b.st[1] = nx; }
        const unsigned old = xb_add(&bar[XB_XSUB(b.x)], 1u);
        const unsigned gen = old / nloc;
        if (old + 1u == (gen + 1u) * nloc) {
            __builtin_amdgcn_fence(__ATOMIC_RELEASE, "agent");
            asm volatile("s_waitcnt vmcnt(0)" ::: "memory");
            const unsigned og = xb_add(&bar[XB_TOP], 1u);
            const unsigned tg = og / nx;
            if (og + 1u == (tg + 1u) * nx) xb_add(&bar[XB_TOPGEN], 1u);
            else XB_SPIN(xb_ld(&bar[XB_TOPGEN]) == tg, bar);
            __builtin_amdgcn_fence(__ATOMIC_ACQUIRE, "agent");
            xb_add(&bar[XB_XGEN(b.x)], 1u);
            asm volatile("s_waitcnt vmcnt(0)" ::: "memory");
        } else {
            XB_SPIN(xb_ld(&bar[XB_XGEN(b.x)]) == gen, bar);
            __builtin_amdgcn_fence(__ATOMIC_ACQUIRE, "agent");
            asm volatile("s_waitcnt vmcnt(0)" ::: "memory");
        }
    }
    __syncthreads();
}

constexpr int NPH_LAYER = 11, NPH = 1 + DEPTH * NPH_LAYER;
#ifndef PROBE_GEMM
#define PROBE_GEMM 0
#endif
template <class E_> __device__ __forceinline__ constexpr int gemm_rep_(const E_&) { return 1 + PROBE_GEMM; }
__device__ __forceinline__ constexpr int gemm_rep_(const pg8::EpiGateAcc&) { return 1; }
#define GEMM_REP(E) gemm_rep_(E)
#ifndef PROBE_ATT
#define PROBE_ATT 0
#endif
#ifndef PROBE_S5
#define PROBE_S5 0
#endif

template <int SP>
__device__ __forceinline__ void layer_phase(const Args& a, const int l, LAS unsigned char* ldsl, unsigned char* lds, const int G, const int bx, const int vcu, const int gw, const int NGW, const int lane_in) {
    int tid_ = threadIdx.x; asm volatile("" : "+v"(tid_));
    const int lane = tid_ & 63; (void)lane_in;
    unsigned char* ws = a.ws;
    const bf16_t* WL = (const bf16_t*)(ws + WS_W + (size_t)l * W_LAYER);
    const float* xin = (l == 0) ? a.in[0] : a.out;
    bf16_t* PROJ = (bf16_t*)(ws + WS_PROJ);
    if constexpr (SP == 0) {
        bf16_t* XN = (bf16_t*)(ws + WS_XN);
        for (int m = gw; m < M; m += 2 * NGW) { const int m2 = (m + NGW < M) ? m + NGW : m; norm_row2(xin + (size_t)m * DM, XN + (size_t)m * DM, xin + (size_t)m2 * DM, XN + (size_t)m2 * DM, lane); }
    } else if constexpr (SP == 1) {
        pg8::Gemm g{(const bf16_t*)(ws + WS_XN), (const bf16_t*)((const char*)WL + W0), M, PROJ_N, DM, DM};
        pg8::StaticOrder S; S.init(M, PROJ_N, G, bx);
        pg8::EpiBf E{PROJ, PROJ_N, 4, 0};
        for (int rep_ = 0; rep_ < GEMM_REP(E); ++rep_) pg8::gemm_phase(ldsl, g, S, E);
    } else if constexpr (SP == 2) {
        { pg8::Gemm g{PROJ, (const bf16_t*)((const char*)WL + W1), M, 768, 256, PROJ_N};
          pg8::StaticOrder S; S.init(M, 768, G, bx);
          pg8::EpiBf E{(bf16_t*)(ws + WS_Q), LDQ, 1 << 30, 0};
          for (int rep_ = 0; rep_ < GEMM_REP(E); ++rep_) pg8::gemm_phase(ldsl, g, S, E); }
        { pg8::Gemm g{PROJ + 256, (const bf16_t*)((const char*)WL + W2), M, 1024, 128, PROJ_N};
          pg8::StaticOrder S; S.init(M, 1024, G, bx);
          pg8::EpiBf E{(bf16_t*)(ws + WS_KV), LDKV, 1 << 30, 1};
          for (int rep_ = 0; rep_ < GEMM_REP(E); ++rep_) pg8::gemm_phase(ldsl, g, S, E); }
        { int t2 = threadIdx.x; asm volatile("" : "+v"(t2)); const int lane2 = t2 & 63, wave2 = __builtin_amdgcn_readfirstlane(t2 >> 6);
        for (int rep = 0; rep < 1 + PROBE_S5; ++rep)
        for (int it = gw; it < BATCH * NG * NCH; it += NGW) s5_item<false>(a, l, it, lane2, ldsl + wave2 * S5_LDS_WAVE); }
    } else if constexpr (SP == 3) {
        for (int m = gw; m < M; m += NGW) postproc_row(a, l, m, lane);
    } else if constexpr (SP == 4) {
        bf16_t* Q = (bf16_t*)(ws + WS_Q); const bf16_t* KV = (const bf16_t*)(ws + WS_KV);
#if PROBE_ATT
        { bf16_t* DUM = (bf16_t*)(ws + WS_YF);
          for (int u = vcu; u < BATCH * NH * (SEQ / 256); u += G) {
            const int bh = u / (SEQ / 256), qb = u % (SEQ / 256), b = bh / NH, h = bh % NH;
            __syncthreads();
            bf16_t* Qb = Q + ((size_t)b * SEQ + (size_t)qb * 256) * LDQ + h * QKD;
            bf16_t* Ob = DUM + ((size_t)b * SEQ + (size_t)qb * 256) * LDQ + h * QKD;
            const bf16_t* Kh = KV + (size_t)b * SEQ * LDKV + h * QKD;
            const bf16_t* Vh = KV + (size_t)b * SEQ * LDKV + 768 + h * VD;
            att::attn_body(Qb, Kh, Vh, Ob, SEQ, (char*)lds);
          }
          cg::this_grid().sync(); }
#endif
        for (int u = vcu; u < BATCH * NH * (SEQ / 256); u += G) {
            const int bh = u / (SEQ / 256), qb = u % (SEQ / 256), b = bh / NH, h = bh % NH;
            __syncthreads();
            bf16_t* Qb = Q + ((size_t)b * SEQ + (size_t)qb * 256) * LDQ + h * QKD;
            const bf16_t* Kh = KV + (size_t)b * SEQ * LDKV + h * QKD;
            const bf16_t* Vh = KV + (size_t)b * SEQ * LDKV + 768 + h * VD;
            bf16_t* Ob = (bf16_t*)(ws + WS_ATT) + ((size_t)b * SEQ + (size_t)qb * 256) * 512 + h * VD;
            att::attn_pp(Qb, Kh, Vh, Ob, 512, SEQ, (char*)lds);
        }
        __syncthreads();
        { int t2 = threadIdx.x; asm volatile("" : "+v"(t2)); const int lane2 = t2 & 63, wave2 = __builtin_amdgcn_readfirstlane(t2 >> 6);
        for (int rep = 0; rep < 1 + PROBE_S5; ++rep)
        for (int it = gw; it < BATCH * NG * NCH; it += NGW) s5_item<true>(a, l, it, lane2, ldsl + wave2 * S5_LDS_WAVE); }
    } else if constexpr (SP == 5) {
        pg8::Gemm g{(const bf16_t*)(ws + WS_YG), (const bf16_t*)((const char*)WL + W4), M, 2048, 512, 512};
        pg8::StaticOrder S; S.init(M, 2048, G, bx);
        pg8::EpiPair<0> E{(bf16_t*)(ws + WS_MIX), DM, PROJ, PROJ_N, 2048};
        for (int rep_ = 0; rep_ < GEMM_REP(E); ++rep_) pg8::gemm_phase(ldsl, g, S, E);
    } else if constexpr (SP == 6) {
        pg8::Gemm g{(const bf16_t*)(ws + WS_ATT), (const bf16_t*)((const char*)WL + W3), M, 1024, 512, 512};
        pg8::StaticOrder S; S.init(M, 1024, G, bx);
        pg8::EpiGateAcc E{(bf16_t*)(ws + WS_MIX), DM, PROJ, PROJ_N, 1024};
        for (int rep_ = 0; rep_ < GEMM_REP(E); ++rep_) pg8::gemm_phase(ldsl, g, S, E);
    } else if constexpr (SP == 7) {
        pg8::Gemm g{(const bf16_t*)(ws + WS_MIX), (const bf16_t*)((const char*)WL + W5), M, 1024, 1024, DM};
        pg8::StaticOrder S; S.init(M, 1024, G, bx);
        pg8::EpiRes E{xin, (float*)(ws + WS_H)};
        for (int rep_ = 0; rep_ < GEMM_REP(E); ++rep_) pg8::gemm_phase(ldsl, g, S, E);
    } else if constexpr (SP == 8) {
        const float* H = (const float*)(ws + WS_H); bf16_t* HN = (bf16_t*)(ws + WS_HN);
        for (int m = gw; m < M; m += 2 * NGW) { const int m2 = (m + NGW < M) ? m + NGW : m; norm_row2(H + (size_t)m * DM, HN + (size_t)m * DM, H + (size_t)m2 * DM, HN + (size_t)m2 * DM, lane); }
    } else if constexpr (SP == 9) {
        pg8::Gemm g{(const bf16_t*)(ws + WS_HN), (const bf16_t*)((const char*)WL + W6), M, 2 * DFF, 1024, DM};
        pg8::StaticOrder S; S.init(M, 2 * DFF, G, bx);
        pg8::EpiPair<1> E{PROJ, DFF, nullptr, 0, 0};
        for (int rep_ = 0; rep_ < GEMM_REP(E); ++rep_) pg8::gemm_phase(ldsl, g, S, E);
    } else {
        pg8::Gemm g{PROJ, (const bf16_t*)((const char*)WL + W7), M, 1024, DFF, DFF};
        pg8::StaticOrder S; S.init(M, 1024, G, bx);
        pg8::EpiRes E{(const float*)(ws + WS_H), a.out};
        for (int rep_ = 0; rep_ < GEMM_REP(E); ++rep_) pg8::gemm_phase(ldsl, g, S, E);
    }
}


__global__ void __launch_bounds__(512) mega_fwd(Args a) {
    __builtin_assume(__builtin_amdgcn_workitem_id_y() == 0); __builtin_assume(__builtin_amdgcn_workitem_id_z() == 0);
    extern __shared__ __attribute__((aligned(16))) unsigned char lds[];
    cg::grid_group grid = cg::this_grid();
    const int tid = threadIdx.x, lane = tid & 63, wave = __builtin_amdgcn_readfirstlane(tid >> 6);
    const int G = gridDim.x, bx = blockIdx.x;
    const int vcu = (G % 8 == 0) ? (bx % 8) * (G / 8) + bx / 8 : bx;
    const int gw = vcu * 8 + wave, NGW = G * 8;
    LAS unsigned char* ldsl = (LAS unsigned char*)lds;
    unsigned char* ws = a.ws;


    const int lo = a.ph_lo, hi = a.ph_hi;
    unsigned* barw = (unsigned*)a.ws;
    volatile LAS unsigned* bst = (volatile LAS unsigned*)(ldsl + 131072);
    if (tid < 2) bst[tid] = 0u;
    if (bx == 0) { for (int i = tid; i < XCD_BAR_WORDS; i += 512) __hip_atomic_store(barw + i, 0u, __ATOMIC_RELAXED, __HIP_MEMORY_SCOPE_AGENT); }
    __syncthreads();
#define IN(k) (lo <= (k) && (k) < hi)
    if (IN(0)) p0_prologue(a, ldsl, gw, NGW, wave, lane);
    grid.sync();
    const XcdBarrier xbar = xcd_barrier_post(barw, bst);
#define SEAM(k) do { if ((k) + 1 < hi) xcd_barrier(xbar); } while (0)
#define LAYER(l) \
    if (IN(1 + (l) * NPH_LAYER + 0))  { layer_phase<0>(a, (l), ldsl, lds, G, bx, vcu, gw, NGW, lane);  SEAM(1 + (l) * NPH_LAYER + 0); } \
    if (IN(1 + (l) * NPH_LAYER + 1))  { layer_phase<1>(a, (l), ldsl, lds, G, bx, vcu, gw, NGW, lane);  SEAM(1 + (l) * NPH_LAYER + 1); } \
    if (IN(1 + (l) * NPH_LAYER + 2))  { layer_phase<2>(a, (l), ldsl, lds, G, bx, vcu, gw, NGW, lane);  SEAM(1 + (l) * NPH_LAYER + 2); } \
    if (IN(1 + (l) * NPH_LAYER + 3))  { layer_phase<3>(a, (l), ldsl, lds, G, bx, vcu, gw, NGW, lane);  SEAM(1 + (l) * NPH_LAYER + 3); } \
    if (IN(1 + (l) * NPH_LAYER + 4))  { layer_phase<4>(a, (l), ldsl, lds, G, bx, vcu, gw, NGW, lane);  SEAM(1 + (l) * NPH_LAYER + 4); } \
    if (IN(1 + (l) * NPH_LAYER + 5))  { layer_phase<5>(a, (l), ldsl, lds, G, bx, vcu, gw, NGW, lane);  SEAM(1 + (l) * NPH_LAYER + 5); } \
    if (IN(1 + (l) * NPH_LAYER + 6))  { layer_phase<6>(a, (l), ldsl, lds, G, bx, vcu, gw, NGW, lane);  SEAM(1 + (l) * NPH_LAYER + 6); } \
    if (IN(1 + (l) * NPH_LAYER + 7))  { layer_phase<7>(a, (l), ldsl, lds, G, bx, vcu, gw, NGW, lane);  SEAM(1 + (l) * NPH_LAYER + 7); } \
    if (IN(1 + (l) * NPH_LAYER + 8))  { layer_phase<8>(a, (l), ldsl, lds, G, bx, vcu, gw, NGW, lane);  SEAM(1 + (l) * NPH_LAYER + 8); } \
    if (IN(1 + (l) * NPH_LAYER + 9))  { layer_phase<9>(a, (l), ldsl, lds, G, bx, vcu, gw, NGW, lane);  SEAM(1 + (l) * NPH_LAYER + 9); } \
    if (IN(1 + (l) * NPH_LAYER + 10)) { layer_phase<10>(a, (l), ldsl, lds, G, bx, vcu, gw, NGW, lane); SEAM(1 + (l) * NPH_LAYER + 10); }
    LAYER(0)
    LAYER(1)
#undef LAYER
#undef IN
#undef SEAM
}

extern "C" void kernel_launch(void* const* d_in, const int* in_sizes, int n_in, void* d_out, int out_size, void* d_ws, size_t ws_size, hipStream_t stream) {
    static int grid = 0;
    if (grid == 0) {
        if (n_in != 25 || in_sizes[0] != M * DM || out_size != M * DM || ws_size < WS_END) {
            fprintf(stderr, "kernel_launch: shape/workspace mismatch (n_in %d, in0 %d, out %d, ws %zu, need %zu); nothing launched\n", n_in, n_in > 0 ? in_sizes[0] : -1, out_size, ws_size, (size_t)WS_END);
            grid = -1; return; }
        int dev = 0, cus = 0, per_cu = 0;
        if (hipGetDevice(&dev) != hipSuccess || hipDeviceGetAttribute(&cus, hipDeviceAttributeMultiprocessorCount, dev) != hipSuccess) { grid = -1; return; }
        if (hipFuncSetAttribute((const void*)mega_fwd, hipFuncAttributeMaxDynamicSharedMemorySize, LDS_BYTES) != hipSuccess) { fprintf(stderr, "kernel_launch: hipFuncSetAttribute failed\n"); grid = -1; return; }
        if (hipOccupancyMaxActiveBlocksPerMultiprocessor(&per_cu, (const void*)mega_fwd, 512, LDS_BYTES) != hipSuccess || per_cu < 1) {
            fprintf(stderr, "kernel_launch: occupancy query reports %d blocks per CU\n", per_cu); per_cu = 1; }
        (void)hipGetLastError();
        grid = cus;
    }
    if (grid < 0) return;
    Args a{};
    for (int i = 0; i < 25; ++i) a.in[i] = (const float*)d_in[i];
    a.out = (float*)d_out; a.ws = (unsigned char*)d_ws; a.ph_lo = 0; a.ph_hi = NPH;
    void* args[] = {&a};
    hipError_t e = hipLaunchCooperativeKernel((const void*)mega_fwd, dim3(grid), dim3(512), args, LDS_BYTES, stream);
    if (e != hipSuccess) fprintf(stderr, "kernel_launch: cooperative launch failed: %s (grid %d)\n", hipGetErrorString(e), grid);
}
```
